# Optimizing an MI355X kernel written in HIP

```python
import math
import jax, jax.numpy as jnp
from jax import lax
import numpy as np

D_MODEL = 1024
BATCH = 8
SEQ = 2048
DEPTH = 4
DEC_BATCH = 128
DEC_SEQ = 1
PAST_LEN = 16384
PAGE_SIZE = 128

A_WIDTH = D_MODEL
A_GROUPS = 8
A_GROUP_DIM = A_WIDTH // A_GROUPS
A_CHUNK = 128
B_HEADS = 8
B_HEAD_DIM = D_MODEL // B_HEADS
B_KEY = B_HEADS * B_HEAD_DIM
B_VAL = B_HEADS * B_HEAD_DIM
CONV_W = 4
CONV_DIM = 2 * B_KEY + B_VAL
B_CHUNK = 64
IN_SIZES = (A_WIDTH, A_WIDTH, A_WIDTH, CONV_DIM, B_VAL, B_HEADS, B_HEADS, D_MODEL, D_MODEL)
IN_DIM = 3 * A_WIDTH + CONV_DIM + B_VAL + 2 * B_HEADS + 2 * D_MODEL
EPS = 1e-6

kernel_name = "hybrid_gmlp_gated_deltanet_decode_step"


def rmsnorm(x, g):
    xf = x.astype(jnp.float32)
    y = xf * lax.rsqrt(jnp.mean(xf * xf, axis=-1, keepdims=True) + EPS)
    return (y * g.astype(jnp.float32)).astype(x.dtype)


def l2norm(x):
    return x * lax.rsqrt(jnp.sum(x * x, axis=-1, keepdims=True) + EPS)


def chunk_spatial_gating(u, v, z, norm_g, w_s, b_s):
    bsz, seq, _ = v.shape
    lc = min(A_CHUNK, seq)
    pad = (-seq) % lc
    vn = rmsnorm(v, norm_g)
    vp = jnp.pad(vn, ((0, 0), (0, pad), (0, 0))) if pad else vn
    n = (seq + pad) // lc
    vc = vp.reshape(bsz, n, lc, A_GROUPS, A_GROUP_DIM)
    causal = jnp.tril(jnp.ones((lc, lc), dtype=bool))
    ws = jnp.where(causal, w_s[:, :lc, :lc], 0).astype(v.dtype)
    bias = b_s[:, :lc].T[None, None, :, :, None].astype(v.dtype)
    mixed = jnp.einsum('gts,bnsgc->bntgc', ws, vc) + bias
    mixed = mixed.reshape(bsz, seq + pad, A_WIDTH)[:, :seq]
    return u * mixed * jax.nn.silu(z), vn


def short_conv(x, buf, w):
    seq = x.shape[1]
    xe = jnp.concatenate([buf.astype(x.dtype), x], axis=1)
    out = sum(xe[:, i:i + seq] * w[i] for i in range(CONV_W))
    return jax.nn.silu(out), xe[:, -(CONV_W - 1):]


def to_chunks(t, n, c):
    b, _, h = t.shape[:3]
    t = t.reshape((b, n, c, h) + t.shape[3:])
    return jnp.moveaxis(t, 3, 1)


def gated_delta(q, k, v, beta, g, s0):
    bsz, seq, nh, _ = q.shape
    dv = v.shape[-1]
    c = min(B_CHUNK, seq)
    pad = (-seq) % c
    if pad:
        padw = lambda t: jnp.pad(t, ((0, 0), (0, pad)) + ((0, 0),) * (t.ndim - 2))
        q, k, v, beta, g = (padw(t) for t in (q, k, v, beta, g))
    n = (seq + pad) // c
    q, k, v, beta, g = (to_chunks(t, n, c) for t in (q, k, v, beta, g))
    gc = jnp.cumsum(g, axis=-1)
    incl = jnp.tril(jnp.ones((c, c), dtype=bool))
    strict = jnp.tril(jnp.ones((c, c), dtype=bool), -1)
    decay = jnp.exp(jnp.where(incl, gc[..., :, None] - gc[..., None, :], -jnp.inf))
    kk = jnp.einsum('bhnid,bhnjd->bhnij', k, k)
    t_mat = jnp.where(strict, beta[..., :, None] * kk * decay, 0.0) + jnp.eye(c, dtype=jnp.float32)
    rhs = jnp.concatenate([v * beta[..., None], k * (beta * jnp.exp(gc))[..., None]], axis=-1)
    sol = lax.linalg.triangular_solve(t_mat, rhs, left_side=True, lower=True, unit_diagonal=True)
    u, w = sol[..., :dv], sol[..., dv:]
    attn = jnp.einsum('bhnid,bhnjd->bhnij', q, k) * decay
    q_dec = q * jnp.exp(gc)[..., None]
    k_dec = k * jnp.exp(gc[..., -1:] - gc)[..., None]
    g_last = jnp.exp(gc[..., -1])

    def step(s, xs):
        u_c, w_c, qd_c, kd_c, a_c, gl_c = xs
        v_new = u_c - jnp.einsum('bhck,bhkv->bhcv', w_c, s)
        o_c = jnp.einsum('bhck,bhkv->bhcv', qd_c, s) + jnp.einsum('bhij,bhjv->bhiv', a_c, v_new)
        s = s * gl_c[..., None, None] + jnp.einsum('bhck,bhcv->bhkv', kd_c, v_new)
        return s, o_c

    xs = tuple(jnp.moveaxis(t, 2, 0) for t in (u, w, q_dec, k_dec, attn, g_last))
    s_fin, o = lax.scan(step, s0, xs)
    o = o.transpose(1, 0, 3, 2, 4).reshape(bsz, n * c, nh, dv)[:, :seq]
    return o, s_fin


def mixer_layer(x, conv_buf, s0, pre_g, w_in, gmlp_g, w_s, b_s, conv_w, a_log, dt_bias, gdn_g, w_pa, w_pb, w_out, post_g):
    bsz, seq, _ = x.shape
    h = rmsnorm(x, pre_g)
    proj = h @ w_in
    splits = np.cumsum(IN_SIZES)[:-1].tolist()
    u_a, v_a, z_a, qkv, z_b, a_b, b_b, gate_a, gate_b = jnp.split(proj, splits, axis=-1)
    y_a, v_rows = chunk_spatial_gating(u_a, v_a, z_a, gmlp_g, w_s, b_s)
    qkv, new_buf = short_conv(qkv, conv_buf, conv_w)
    qkv = qkv.astype(jnp.float32)
    hs = (bsz, seq, B_HEADS, B_HEAD_DIM)
    q = l2norm(qkv[..., :B_KEY].reshape(hs)) * (B_HEAD_DIM ** -0.5)
    k = l2norm(qkv[..., B_KEY:2 * B_KEY].reshape(hs))
    v = qkv[..., 2 * B_KEY:].reshape(hs)
    beta = jax.nn.sigmoid(b_b.astype(jnp.float32))
    g = -jnp.exp(a_log.astype(jnp.float32)) * jax.nn.softplus(a_b.astype(jnp.float32) + dt_bias.astype(jnp.float32))
    o, s_new = gated_delta(q, k, v, beta, g, s0.astype(jnp.float32))
    o = rmsnorm(o, gdn_g) * jax.nn.silu(z_b.astype(jnp.float32).reshape(hs))
    y_b = o.reshape(bsz, seq, B_VAL).astype(x.dtype)
    merged = jax.nn.sigmoid(gate_a) * (y_a @ w_pa) + jax.nn.sigmoid(gate_b) * (y_b @ w_pb)
    out = merged @ w_out
    return x + rmsnorm(out, post_g), new_buf, s_new, v_rows


def setup_inputs(seed: int = 0) -> dict:
    key = jax.random.key(seed)
    ks = jax.random.split(key, 17)
    nrm = lambda k, shape, scale: jax.random.normal(k, shape, jnp.float32) * scale
    dt = jnp.exp(jax.random.uniform(ks[11], (DEPTH, B_HEADS), jnp.float32, math.log(1e-3), math.log(1e-1)))
    return {
        "x_prompt": nrm(ks[0], (BATCH, SEQ, D_MODEL), 1.0),
        "x_sample": nrm(ks[1], (DEC_BATCH, DEC_SEQ, D_MODEL), 1.0),
        "state_gdn": nrm(ks[2], (DEPTH, DEC_BATCH, B_HEADS, B_HEAD_DIM, B_HEAD_DIM), 0.1),
        "state_conv": nrm(ks[3], (DEPTH, DEC_BATCH, CONV_W - 1, CONV_DIM), 1.0),
        "pre_norm": 1.0 + nrm(ks[4], (DEPTH, D_MODEL), 0.02),
        "w_in": nrm(ks[5], (DEPTH, D_MODEL, IN_DIM), D_MODEL ** -0.5),
        "gmlp_norm": 1.0 + nrm(ks[6], (DEPTH, A_WIDTH), 0.02),
        "w_spatial": nrm(ks[7], (DEPTH, A_GROUPS, A_CHUNK, A_CHUNK), A_CHUNK ** -0.5),
        "b_spatial": 1.0 + nrm(ks[8], (DEPTH, A_GROUPS, A_CHUNK), 0.02),
        "conv_w": nrm(ks[9], (DEPTH, CONV_W, CONV_DIM), CONV_W ** -0.5),
        "a_log": jnp.log(jax.random.uniform(ks[10], (DEPTH, B_HEADS), jnp.float32, 1.0, 16.0)),
        "dt_bias": dt + jnp.log(-jnp.expm1(-dt)),
        "gdn_norm": 1.0 + nrm(ks[12], (DEPTH, B_HEAD_DIM), 0.02),
        "w_proj_a": nrm(ks[13], (DEPTH, A_WIDTH, D_MODEL), A_WIDTH ** -0.5),
        "w_proj_b": nrm(ks[14], (DEPTH, B_VAL, D_MODEL), B_VAL ** -0.5),
        "w_out": nrm(ks[15], (DEPTH, D_MODEL, D_MODEL), D_MODEL ** -0.5),
        "post_norm": 1.0 + nrm(ks[16], (DEPTH, D_MODEL), 0.02),
    }


def reference(x_prompt, x_sample, state_gdn, state_conv, pre_norm, w_in, gmlp_norm, w_spatial, b_spatial, conv_w, a_log, dt_bias, gdn_norm, w_proj_a, w_proj_b, w_out, post_norm):
    bp = x_prompt.shape[0]
    conv_zero = jnp.zeros((bp, CONV_W - 1, CONV_DIM), x_prompt.dtype)
    s_zero = jnp.zeros((bp, B_HEADS, B_HEAD_DIM, B_HEAD_DIM), jnp.float32)
    xp, xs = x_prompt, x_sample
    gdn_p, conv_p, gdn_s, conv_s, vrows_s = [], [], [], [], []
    for l in range(DEPTH):
        w = (pre_norm[l], w_in[l], gmlp_norm[l], w_spatial[l], b_spatial[l], conv_w[l], a_log[l], dt_bias[l],
             gdn_norm[l], w_proj_a[l], w_proj_b[l], w_out[l], post_norm[l])
        xp, cb_p, sg_p, _ = mixer_layer(xp, conv_zero, s_zero, *w)
        xs, cb_s, sg_s, vr_s = mixer_layer(xs, state_conv[l], state_gdn[l], *w)
        gdn_p.append(sg_p)
        conv_p.append(cb_p)
        gdn_s.append(sg_s)
        conv_s.append(cb_s)
        vrows_s.append(vr_s)
    return (xp, xs, jnp.stack(gdn_p), jnp.stack(conv_p), jnp.stack(gdn_s), jnp.stack(conv_s), jnp.stack(vrows_s))
```

```cpp
#include <hip/hip_runtime.h>
#include <hip/hip_cooperative_groups.h>
#include <cstdio>
namespace cg = cooperative_groups;
namespace pg8 {
#define PG8_LAS __attribute__((address_space(3)))
typedef unsigned short bf16_t;
typedef short bf16x8 __attribute__((ext_vector_type(8)));
typedef float f32x4 __attribute__((ext_vector_type(4)));
typedef unsigned u32x4 __attribute__((ext_vector_type(4)));
constexpr int BM = 256, BK = 64, HALF = 128, HTB = HALF * BK * 2  , STAGE_BYTES = 8 * HTB, NXCD = 8, WGM = 8;

__host__ __device__ __forceinline__ int lds_byte(int r, int c) { const int st = (r >> 4) * 2 + (c >> 5), rr = r & 15, cc = c & 31, ob = rr * 64 + cc * 2; return st * 1024 + (ob ^ (((ob >> 9) & 1) << 5)); }
__host__ __device__ __forceinline__ void stage_rc(int b, int& R, int& C) { const int st = b / 1024, sb = b % 1024, swz = sb ^ (((sb >> 9) & 1) << 5); R = (st >> 1) * 16 + swz / 64; C = (st & 1) * 32 + (swz % 64) / 2; }
__host__ __device__ __forceinline__ int perm32(int rho) { const int n = rho >> 4, i = rho & 15; return 8 * (i >> 2) + 4 * n + (i & 3); }

struct Unit { int pm, pn; };
struct Gemm { const bf16_t* A; const bf16_t* Bt; int M, N, K; };

struct StaticOrder {
    int nM, nN, nwg, G, c;
    __host__ __device__ void init(int M, int N, int G_, int c_) { nM = M / BM; nN = N / BM; nwg = nM * nN; G = G_; c = c_; }
    __host__ __device__ bool next(int i, Unit& u) const {
        const long L = (long)i * G + c; if (L >= nwg) return false;
        int wgid = (int)L; { const int q = nwg / NXCD, r = nwg % NXCD, xcd = wgid % NXCD, off = wgid / NXCD; wgid = (xcd < r ? xcd * (q + 1) : r * (q + 1) + (xcd - r) * q) + off; }
        const int nig = WGM * nN, gid = wgid / nig, fm = gid * WGM, gsz = (nM - fm) < WGM ? (nM - fm) : WGM;
        u.pm = fm + ((wgid % nig) % gsz); u.pn = (wgid % nig) / gsz; return true;
    }
    __device__ __forceinline__ void a_ready(const Unit&) const {}
    __device__ __forceinline__ void done(const Unit&) const {}
};
typedef float f32x2c __attribute__((ext_vector_type(2))); typedef __bf16 bf16x2c __attribute__((ext_vector_type(2)));
__device__ __forceinline__ unsigned cvt_pk_bf16(float lo, float hi) { const f32x2c v = {lo, hi}; const bf16x2c r = __builtin_convertvector(v, bf16x2c); return __builtin_bit_cast(unsigned, r); }
template <class Epi, class Sched, bool STAMP = false>
__device__ __forceinline__ void gemm_phase(PG8_LAS unsigned char* lds, const Gemm g, const Sched& S, const Epi& E, unsigned long long* stamps) {
    int tid_opq = threadIdx.x; asm volatile("" : "+v"(tid_opq));
    const int tid = tid_opq, wid = __builtin_amdgcn_readfirstlane(tid >> 6), lane = tid & 63, wr = wid >> 2, wc = wid & 3, fr = lane & 15, fq = lane >> 4;
    const int K = g.K, nt = K / BK;
    int ts_lo = 0, ts_hi = 0, nts = 0; const unsigned long long rt_entry = STAMP ? (unsigned long long)wall_clock64() : 0ull;
#define PG8_STAMP() do { if (STAMP && wid == 0 && nts < 64) { const unsigned long long _c = (unsigned long long)clock64(); \
        ts_lo = (lane == nts) ? (int)(unsigned)_c : ts_lo; ts_hi = (lane == nts) ? (int)(unsigned)(_c >> 32) : ts_hi; ++nts; } } while (0)
    PG8_STAMP();
    unsigned voffA[2], voffB[2];
#pragma unroll
    for (int i = 0; i < 2; ++i) { int R, C; stage_rc(tid * 16 + i * 8192, R, C); const int Rb = Epi::PERM ? ((R & ~31) + perm32(R & 31)) : R;
        voffA[i] = (unsigned)(R * K + C) * 2u; voffB[i] = (unsigned)(Rb * K + C) * 2u; }
    const size_t kstep = (size_t)(BK * 2);
    const size_t hstep = (size_t)HALF * K * 2;
    const size_t tstep = 2 * hstep;
    const unsigned ldsw = (unsigned)wid * 1024u;
    const int aoff = lds_byte(wr * 64 + fr, fq * 8), boff = lds_byte(wc * 32 + fr, fq * 8);
#define PG8_SA(b, h) (((b) * 2 + (h)) * HTB)
#define PG8_SB(b, h) ((4 + (b) * 2 + (h)) * HTB)
#define PG8_STAGE(bufoff, gbase, voff) do { _Pragma("unroll") for (int _i = 0; _i < 2; ++_i) \
        __builtin_amdgcn_global_load_lds((const unsigned*)((const char*)(gbase) + (voff)[_i]), (PG8_LAS unsigned*)(lds + (bufoff) + ldsw + _i * 8192), 16, 0, 0); } while (0)
#define PG8_LDA(dst, b, h) do { _Pragma("unroll") for (int m = 0; m < 4; ++m) _Pragma("unroll") for (int k = 0; k < 2; ++k) dst[m][k] = *(const PG8_LAS bf16x8*)(lds + PG8_SA(b, h) + aoff + m * 2048 + k * 1024); } while (0)
#define PG8_LDB(dst, b, h) do { _Pragma("unroll") for (int n = 0; n < 2; ++n) _Pragma("unroll") for (int k = 0; k < 2; ++k) dst[n][k] = *(const PG8_LAS bf16x8*)(lds + PG8_SB(b, h) + boff + n * 2048 + k * 1024); } while (0)
#define PG8_MMA(ai, bj, At, Bt) do { __builtin_amdgcn_s_setprio(1); _Pragma("unroll") for (int m = 0; m < 4; ++m) _Pragma("unroll") for (int n = 0; n < 2; ++n) _Pragma("unroll") for (int k = 0; k < 2; ++k) \
        acc[ai][bj][m][n] = __builtin_amdgcn_mfma_f32_16x16x32_bf16(Bt[n][k], At[m][k], acc[ai][bj][m][n], 0, 0, 0); __builtin_amdgcn_s_setprio(0); } while (0)
#define PG8_WAIT_V(n) asm volatile("s_waitcnt vmcnt(" #n ")" ::: "memory")
#define PG8_WAIT_L(n) asm volatile("s_waitcnt lgkmcnt(" #n ")" ::: "memory")
#define PG8_BAR __builtin_amdgcn_s_barrier()
#define PG8_SCHED __builtin_amdgcn_sched_barrier(0)
    Unit cur, nxt; int ui = 0;
    if (!S.next(0, cur)) return;
    f32x4 acc[2][2][4][2];
#pragma unroll
    for (int a = 0; a < 2; ++a)
#pragma unroll
        for (int b = 0; b < 2; ++b)
#pragma unroll
            for (int m = 0; m < 4; ++m)
#pragma unroll
                for (int n = 0; n < 2; ++n) acc[a][b][m][n] = (f32x4){0.f, 0.f, 0.f, 0.f};
    bf16x8 At[4][2], B0[2][2], B1[2][2];
    const char* cA = (const char*)g.A + (size_t)cur.pm * tstep; const char* cB = (const char*)g.Bt + (size_t)cur.pn * tstep;
    S.a_ready(cur);
    PG8_STAGE(PG8_SB(0, 0), cB, voffB); PG8_STAGE(PG8_SA(0, 0), cA, voffA); PG8_STAGE(PG8_SB(0, 1), cB + hstep, voffB); PG8_STAGE(PG8_SA(0, 1), cA + hstep, voffA);
    if (wr == 1) PG8_BAR;
    PG8_WAIT_V(4); PG8_BAR;
    PG8_STAGE(PG8_SB(1, 0), cB + kstep, voffB); PG8_STAGE(PG8_SA(1, 0), cA + kstep, voffA); PG8_STAGE(PG8_SB(1, 1), cB + hstep + kstep, voffB);
    PG8_WAIT_V(6); PG8_BAR;
    PG8_STAMP();
    for (;;) {
        const bool has_next = S.next(ui + 1, nxt);
        const char* nA = has_next ? (const char*)g.A + (size_t)nxt.pm * tstep : cA; const char* nB = has_next ? (const char*)g.Bt + (size_t)nxt.pn * tstep : cB;
        for (int t = 0; t < nt; t += 2) {
            const bool last = (t == nt - 2);
            const char* a1 = cA + (size_t)(t + 1) * kstep;
            const char* a2 = last ? nA : cA + (size_t)(t + 2) * kstep; const char* b2 = last ? nB : cB + (size_t)(t + 2) * kstep;
            const char* a3 = a2 + kstep; const char* b3 = b2 + kstep;
            if (last && has_next) S.a_ready(nxt);
            PG8_LDB(B0, 0, 0); PG8_SCHED; PG8_LDA(At, 0, 0); PG8_STAGE(PG8_SA(1, 1), a1 + hstep, voffA);
            PG8_WAIT_L(8); PG8_BAR; PG8_WAIT_L(0); PG8_MMA(0, 0, At, B0); PG8_BAR; PG8_SCHED;
            PG8_LDB(B1, 0, 1); PG8_STAGE(PG8_SB(0, 0), b2, voffB);
            PG8_BAR; PG8_WAIT_L(0); PG8_MMA(0, 1, At, B1); PG8_BAR;
            PG8_LDA(At, 0, 1); PG8_STAGE(PG8_SA(0, 0), a2, voffA);
            PG8_BAR; PG8_WAIT_L(0); PG8_MMA(1, 0, At, B0); PG8_BAR; PG8_SCHED;
            PG8_STAGE(PG8_SB(0, 1), b2 + hstep, voffB);
            PG8_WAIT_V(6); PG8_BAR; PG8_MMA(1, 1, At, B1); PG8_BAR;
            PG8_LDB(B0, 1, 0); PG8_SCHED; PG8_LDA(At, 1, 0); PG8_STAGE(PG8_SA(0, 1), a2 + hstep, voffA);
            PG8_WAIT_L(8); PG8_BAR; PG8_WAIT_L(0); PG8_MMA(0, 0, At, B0); PG8_BAR; PG8_SCHED;
            PG8_LDB(B1, 1, 1); PG8_STAGE(PG8_SB(1, 0), b3, voffB);
            PG8_BAR; PG8_WAIT_L(0); PG8_MMA(0, 1, At, B1); PG8_BAR;
            PG8_LDA(At, 1, 1); PG8_STAGE(PG8_SA(1, 0), a3, voffA);
            PG8_BAR; PG8_WAIT_L(0); PG8_MMA(1, 0, At, B0); PG8_BAR; PG8_SCHED;
            PG8_STAGE(PG8_SB(1, 1), b3 + hstep, voffB);
            PG8_WAIT_V(6); PG8_BAR; PG8_MMA(1, 1, At, B1); PG8_BAR;
        }
        PG8_STAMP();
        if constexpr (!Epi::AFTER_DRAIN) { E(acc, cur, wr, wc, fr, fq); S.done(cur); }
        PG8_STAMP();
        if (!has_next) break;
#pragma unroll
        for (int a = 0; a < 2; ++a)
#pragma unroll
            for (int b = 0; b < 2; ++b)
#pragma unroll
                for (int m = 0; m < 4; ++m)
#pragma unroll
                    for (int n = 0; n < 2; ++n) acc[a][b][m][n] = (f32x4){0.f, 0.f, 0.f, 0.f};
        cur = nxt; cA = nA; cB = nB; ++ui;
    }
    PG8_WAIT_V(0);
    if (wr == 0) PG8_BAR;
    PG8_BAR;
    if constexpr (Epi::AFTER_DRAIN) { E.fused(acc, cur, wr, wc, fr, fq, lds, wid, lane); S.done(cur); }
    PG8_STAMP();
    if (STAMP && wid == 0) { stamps[lane] = lane < nts ? (((unsigned long long)(unsigned)ts_hi << 32) | (unsigned)ts_lo) : 0ull;
        if (lane == 62) stamps[62] = rt_entry; if (lane == 63) stamps[63] = (unsigned long long)wall_clock64(); }
#undef PG8_STAMP
#undef PG8_SA
#undef PG8_SB
#undef PG8_STAGE
#undef PG8_LDA
#undef PG8_LDB
#undef PG8_MMA
#undef PG8_WAIT_V
#undef PG8_WAIT_L
#undef PG8_BAR
#undef PG8_SCHED
}
}
using pg8::bf16_t; using pg8::bf16x8; using pg8::f32x4; using pg8::u32x4; using pg8::Unit;
typedef unsigned u32x2 __attribute__((ext_vector_type(2)));
#define LAS __attribute__((address_space(3)))

constexpr int D = 1024, NB = 8, SEQ = 2048, DEPTH = 4, DB = 128, TP = NB * SEQ, TT = TP + DB, MP = 16640;
constexpr int INDIM = 9232, NPROJ = 9216, NW1 = 9472, CONVD = 3072;
constexpr int C_U = 0, C_V = 1024, C_Z = 2048, C_QKV = 3072, C_ZB = 6144, C_GA = 7168, C_GB = 8192;
constexpr float EPS = 1e-6f;
constexpr int NTHR = 512;
constexpr int LDS_BYTES = 147456;
constexpr size_t MiB = 1u << 20;
constexpr size_t WS_W1T = 1 * MiB, WS_WPA = 75 * MiB, WS_WPB = 83 * MiB, WS_WOUT = 91 * MiB, WS_H = 99 * MiB, WS_PROJ = 132 * MiB,
                 WS_AB = 425 * MiB, WS_YA = 427 * MiB, WS_YB = 460 * MiB, WS_REC = 493 * MiB, WS_TMP = 493 * MiB, WS_MERGED = 560 * MiB,
                 WS_GL = 669 * MiB, WS_END = 670 * MiB;
constexpr int REC_BYTES = 90112, REC_W = 0, REC_QD = 16384, REC_ATT = 32768, REC_KDT = 40960, REC_UT = 57344;
constexpr size_t O_Y = 0, O_GP = 16908288, O_CP = 21102592, O_GS = 21397504, O_CS = 88506368, O_VS = 93224960;

struct Args { const float* in[17]; float* out; unsigned char* ws; };

__device__ __forceinline__ float sigm(float x) { return 1.0f / (1.0f + __expf(-x)); }
__device__ __forceinline__ float silu(float x) { return x * sigm(x); }
__device__ __forceinline__ unsigned pk2(float lo, float hi) { return pg8::cvt_pk_bf16(lo, hi); }
__device__ __forceinline__ float bflo(unsigned w) { return __uint_as_float(w << 16); }
__device__ __forceinline__ float bfhi(unsigned w) { return __uint_as_float(w & 0xffff0000u); }
__device__ __forceinline__ float bf1(bf16_t b) { return __uint_as_float((unsigned)b << 16); }
__device__ __forceinline__ bf16_t f2bf(float f) { return (bf16_t)(pk2(f, 0.f) & 0xffffu); }
__device__ __forceinline__ void unpack8(const u32x4 w, float* f) { f[0] = bflo(w.x); f[1] = bfhi(w.x); f[2] = bflo(w.y); f[3] = bfhi(w.y); f[4] = bflo(w.z); f[5] = bfhi(w.z); f[6] = bflo(w.w); f[7] = bfhi(w.w); }
__device__ __forceinline__ float wave_sum(float v) {
#pragma unroll
    for (int o = 1; o < 64; o <<= 1) v += __shfl_xor(v, o);
    return v;
}
__device__ __forceinline__ bf16x8 as_bf16x8(u32x4 w) { return __builtin_bit_cast(bf16x8, w); }

struct Epi1 {
    static constexpr bool PERM = true, AFTER_DRAIN = false;
    bf16_t* P; float* AB;
    __device__ __forceinline__ void operator()(const f32x4 (&acc)[2][2][4][2], const Unit& u, int wr, int wc, int fr, int fq) const {
        const int row0 = u.pm * 256 + wr * 64 + fr;
        if (u.pn < 36) {
            const int col0 = u.pn * 256 + wc * 32 + 8 * fq;
#pragma unroll
            for (int ai = 0; ai < 2; ++ai)
#pragma unroll
                for (int m = 0; m < 4; ++m) { bf16_t* rowp = P + (size_t)(row0 + ai * 128 + m * 16) * NPROJ + col0;
#pragma unroll
                    for (int bj = 0; bj < 2; ++bj) { const f32x4 v0 = acc[ai][bj][m][0], v1 = acc[ai][bj][m][1];
                        u32x4 w; w.x = pk2(v0[0], v0[1]); w.y = pk2(v0[2], v0[3]); w.z = pk2(v1[0], v1[1]); w.w = pk2(v1[2], v1[3]);
                        *(u32x4*)(rowp + bj * 128) = w; } }
        } else if (wc == 0 && fq < 2) {
#pragma unroll
            for (int ai = 0; ai < 2; ++ai)
#pragma unroll
                for (int m = 0; m < 4; ++m) { float* rp = AB + (size_t)(row0 + ai * 128 + m * 16) * 16 + 8 * fq;
                    *(f32x4*)rp = acc[ai][0][m][0]; *(f32x4*)(rp + 4) = acc[ai][0][m][1]; }
        }
    }
};
struct Epi2a {
    static constexpr bool PERM = true, AFTER_DRAIN = false;
    const bf16_t* P; float* TMP;
    __device__ __forceinline__ void operator()(const f32x4 (&acc)[2][2][4][2], const Unit& u, int wr, int wc, int fr, int fq) const {
        const int row0 = u.pm * 256 + wr * 64 + fr, col0 = u.pn * 256 + wc * 32 + 8 * fq;
#pragma unroll
        for (int ai = 0; ai < 2; ++ai)
#pragma unroll
            for (int m = 0; m < 4; ++m) { const size_t r = (size_t)(row0 + ai * 128 + m * 16);
#pragma unroll
                for (int bj = 0; bj < 2; ++bj) { const int c = col0 + bj * 128;
                    const u32x4 gw = *(const u32x4*)(P + r * NPROJ + C_GA + c); float g[8]; unpack8(gw, g);
                    const f32x4 v0 = acc[ai][bj][m][0], v1 = acc[ai][bj][m][1];
                    f32x4 o0, o1;
#pragma unroll
                    for (int j = 0; j < 4; ++j) { o0[j] = v0[j] * sigm(g[j]); o1[j] = v1[j] * sigm(g[4 + j]); }
                    *(f32x4*)(TMP + r * D + c) = o0; *(f32x4*)(TMP + r * D + c + 4) = o1; } }
    }
};
struct Epi2b {
    static constexpr bool PERM = true, AFTER_DRAIN = false;
    const bf16_t* P; const float* TMP; bf16_t* MG;
    __device__ __forceinline__ void operator()(const f32x4 (&acc)[2][2][4][2], const Unit& u, int wr, int wc, int fr, int fq) const {
        const int row0 = u.pm * 256 + wr * 64 + fr, col0 = u.pn * 256 + wc * 32 + 8 * fq;
#pragma unroll
        for (int ai = 0; ai < 2; ++ai)
#pragma unroll
            for (int m = 0; m < 4; ++m) { const size_t r = (size_t)(row0 + ai * 128 + m * 16);
#pragma unroll
                for (int bj = 0; bj < 2; ++bj) { const int c = col0 + bj * 128;
                    const u32x4 gw = *(const u32x4*)(P + r * NPROJ + C_GB + c); float g[8]; unpack8(gw, g);
                    const f32x4 t0 = *(const f32x4*)(TMP + r * D + c), t1 = *(const f32x4*)(TMP + r * D + c + 4);
                    const f32x4 v0 = acc[ai][bj][m][0], v1 = acc[ai][bj][m][1];
                    f32x4 o0, o1;
#pragma unroll
                    for (int j = 0; j < 4; ++j) { o0[j] = t0[j] + v0[j] * sigm(g[j]); o1[j] = t1[j] + v1[j] * sigm(g[4 + j]); }
                    u32x4 w; w.x = pk2(o0[0], o0[1]); w.y = pk2(o0[2], o0[3]); w.z = pk2(o1[0], o1[1]); w.w = pk2(o1[2], o1[3]);
                    *(u32x4*)(MG + r * D + c) = w; } }
    }
};
struct Epi3 {
    static constexpr bool PERM = false, AFTER_DRAIN = false;
    float* C;
    __device__ __forceinline__ void operator()(const f32x4 (&acc)[2][2][4][2], const Unit& u, int wr, int wc, int fr, int fq) const {
        const int row0 = u.pm * 256 + wr * 64 + fr, col0 = u.pn * 256 + wc * 32 + 4 * fq;
#pragma unroll
        for (int ai = 0; ai < 2; ++ai)
#pragma unroll
            for (int m = 0; m < 4; ++m) { float* rowp = C + (size_t)(row0 + ai * 128 + m * 16) * D + col0;
#pragma unroll
                for (int bj = 0; bj < 2; ++bj)
#pragma unroll
                    for (int n = 0; n < 2; ++n) *(f32x4*)(rowp + bj * 128 + n * 16) = acc[ai][bj][m][n]; }
    }
};
__device__ __forceinline__ void p0_transpose_item(const float* W, int nsrc, bf16_t* WT, float* scr, int item, int nblk, int lane, int mode) {
    const int kb = item / nblk, nb = item % nblk, k0 = 64 * kb, n0 = 32 * nb;
    const int n = n0 + (lane & 31);
    int sc = n;
    if (mode == 1) sc = (n < 7168) ? n : (n < 9216 ? n + 16 : (n < 9232 ? n - 9216 + 7168 : -1));
#pragma unroll 8
    for (int i = 0; i < 32; ++i) { const int kk = 2 * i + (lane >> 5); scr[kk * 33 + (lane & 31)] = (sc >= 0) ? W[(size_t)(k0 + kk) * nsrc + sc] : 0.f; }
    asm volatile("s_waitcnt lgkmcnt(0)" ::: "memory");
    const int c = lane & 7;
#pragma unroll
    for (int j = 0; j < 4; ++j) { const int nn = (lane >> 3) + 8 * j; const float* s = scr + (8 * c) * 33 + nn;
        u32x4 o; o.x = pk2(s[0 * 33], s[1 * 33]); o.y = pk2(s[2 * 33], s[3 * 33]); o.z = pk2(s[4 * 33], s[5 * 33]); o.w = pk2(s[6 * 33], s[7 * 33]);
        *(u32x4*)(WT + (size_t)(n0 + nn) * 1024 + k0 + 8 * c) = o; }
    asm volatile("s_waitcnt lgkmcnt(0)" ::: "memory");
}
__device__ __forceinline__ void rms_row_to_bf16(const float* xrow, const float* g, bf16_t* orow, int lane) {
    const f32x4* xr = (const f32x4*)xrow + lane; const f32x4* gr = (const f32x4*)g + lane;
    f32x4 v[4]; float s = 0.f;
#pragma unroll
    for (int j = 0; j < 4; ++j) { v[j] = xr[64 * j]; s += (v[j][0] * v[j][0] + v[j][1] * v[j][1]) + (v[j][2] * v[j][2] + v[j][3] * v[j][3]); }
    const float rstd = rsqrtf(wave_sum(s) * (1.f / D) + EPS);
    u32x2* o8 = (u32x2*)orow + lane;
#pragma unroll
    for (int j = 0; j < 4; ++j) { const f32x4 gg = gr[64 * j]; u32x2 w; w.x = pk2(v[j][0] * rstd * gg[0], v[j][1] * rstd * gg[1]); w.y = pk2(v[j][2] * rstd * gg[2], v[j][3] * rstd * gg[3]); o8[64 * j] = w; }
}
__device__ __forceinline__ void phase_prologue(const Args& a, unsigned char* lds, int wg, int G, int tid) {
    asm volatile("" : "+v"(tid));
    const int wave = tid >> 6, lane = tid & 63;
    float* scr = (float*)(lds + wave * 16384);
    const int gw = wg * 8 + wave, NGW = G * 8;
    constexpr int I_IN = 16 * (NW1 / 32), I_SQ = 16 * 32, PER_L = I_IN + 3 * I_SQ, NITEMS = DEPTH * PER_L;
    for (int it = gw; it < NITEMS; it += NGW) {
        const int l = it / PER_L; int r = it % PER_L;
        if (r < I_IN) { p0_transpose_item(a.in[5] + (size_t)l * D * INDIM, INDIM, (bf16_t*)(a.ws + WS_W1T) + (size_t)l * NW1 * D, scr, r, NW1 / 32, lane, 1); continue; } r -= I_IN;
        if (r < I_SQ) { p0_transpose_item(a.in[13] + (size_t)l * D * D, D, (bf16_t*)(a.ws + WS_WPA) + (size_t)l * D * D, scr, r, 32, lane, 0); continue; } r -= I_SQ;
        if (r < I_SQ) { p0_transpose_item(a.in[14] + (size_t)l * D * D, D, (bf16_t*)(a.ws + WS_WPB) + (size_t)l * D * D, scr, r, 32, lane, 0); continue; } r -= I_SQ;
        p0_transpose_item(a.in[15] + (size_t)l * D * D, D, (bf16_t*)(a.ws + WS_WOUT) + (size_t)l * D * D, scr, r, 32, lane, 0);
    }
    bf16_t* H = (bf16_t*)(a.ws + WS_H);
    for (int m = gw; m < MP; m += NGW) {
        if (m < TT) { const float* xr = (m < TP) ? a.in[0] + (size_t)m * D : a.in[1] + (size_t)(m - TP) * D; rms_row_to_bf16(xr, a.in[4], H + (size_t)m * D, lane); }
        else { u32x4 z = {0u, 0u, 0u, 0u}; u32x4* o = (u32x4*)(H + (size_t)m * D) + lane; o[0] = z; o[64] = z; }
    }
}
__device__ __forceinline__ void phase_residual(const Args& a, int l, int wg, int G, int tid) {
    asm volatile("" : "+v"(tid));
    const int wave = tid >> 6, lane = tid & 63; const int gw = wg * 8 + wave, NGW = G * 8;
    const float* OUT = (const float*)(a.ws + WS_TMP); bf16_t* H = (bf16_t*)(a.ws + WS_H);
    const f32x4* pg = (const f32x4*)(a.in[16] + (size_t)l * D) + lane;
    const f32x4* ng = (const f32x4*)(a.in[4] + (size_t)((l + 1 < DEPTH) ? l + 1 : l) * D) + lane;
    for (int m = gw; m < TT; m += NGW) {
        const float* xs = (l == 0) ? ((m < TP) ? a.in[0] + (size_t)m * D : a.in[1] + (size_t)(m - TP) * D) : a.out + O_Y + (size_t)m * D;
        const f32x4* orow = (const f32x4*)(OUT + (size_t)m * D) + lane; const f32x4* xr = (const f32x4*)xs + lane;
        f32x4 v[4], x[4]; float s = 0.f;
#pragma unroll
        for (int j = 0; j < 4; ++j) { v[j] = orow[64 * j]; x[j] = xr[64 * j]; s += (v[j][0] * v[j][0] + v[j][1] * v[j][1]) + (v[j][2] * v[j][2] + v[j][3] * v[j][3]); }
        const float rs = rsqrtf(wave_sum(s) * (1.f / D) + EPS); float s2 = 0.f;
        f32x4* xo = (f32x4*)(a.out + O_Y + (size_t)m * D) + lane;
#pragma unroll
        for (int j = 0; j < 4; ++j) { const f32x4 g = pg[64 * j]; x[j] = x[j] + v[j] * rs * g; xo[64 * j] = x[j]; s2 += (x[j][0] * x[j][0] + x[j][1] * x[j][1]) + (x[j][2] * x[j][2] + x[j][3] * x[j][3]); }
        if (l + 1 < DEPTH) {
            const float r2 = rsqrtf(wave_sum(s2) * (1.f / D) + EPS); u32x2* o8 = (u32x2*)(H + (size_t)m * D) + lane;
#pragma unroll
            for (int j = 0; j < 4; ++j) { const f32x4 g = ng[64 * j]; u32x2 w; w.x = pk2(x[j][0] * r2 * g[0], x[j][1] * r2 * g[1]); w.y = pk2(x[j][2] * r2 * g[2], x[j][3] * r2 * g[3]); o8[64 * j] = w; }
        }
    }
}
__device__ __forceinline__ void task_gmlp_prompt(const Args& a, int l, unsigned char* lds, int task, int tid) {
    asm volatile("" : "+v"(tid));
    const int chunk = task >> 3, g = task & 7, r0 = chunk * 128;
    const int wave = tid >> 6, lane = tid & 63, l15 = lane & 15, q = lane >> 4;
    const bf16_t* P = (const bf16_t*)(a.ws + WS_PROJ); bf16_t* YA = (bf16_t*)(a.ws + WS_YA);
    float* rstd = (float*)lds;
    bf16_t* WsA = (bf16_t*)(lds + 1024);
    bf16_t* VT = (bf16_t*)(lds + 1024 + 34816);
    float* MIX = (float*)(lds + 1024 + 2 * 34816);
    {
        const int row = tid >> 2, part = tid & 3; const u32x4* vp = (const u32x4*)(P + (size_t)(r0 + row) * NPROJ + C_V + part * 256);
        float s = 0.f;
#pragma unroll 8
        for (int i = 0; i < 32; ++i) { float f[8]; unpack8(vp[i], f);
#pragma unroll
            for (int j = 0; j < 8; ++j) s += f[j] * f[j]; }
        s += __shfl_xor(s, 1); s += __shfl_xor(s, 2);
        if (part == 0) rstd[row] = rsqrtf(s * (1.f / D) + EPS);
    }
    {
        const float* Ws = a.in[7] + ((size_t)l * 8 + g) * 128 * 128;
#pragma unroll
        for (int i = 0; i < 8; ++i) { const int idx = tid + 512 * i, t = idx >> 5, s4 = (idx & 31) * 4; const f32x4 w = *(const f32x4*)(Ws + t * 128 + s4);
            u32x2 o; o.x = pk2(s4 <= t ? w[0] : 0.f, s4 + 1 <= t ? w[1] : 0.f); o.y = pk2(s4 + 2 <= t ? w[2] : 0.f, s4 + 3 <= t ? w[3] : 0.f);
            *(u32x2*)(WsA + t * 136 + s4) = o; }
    }
    __syncthreads();
    {
        const float* gn = a.in[6] + (size_t)l * D + g * 128;
#pragma unroll
        for (int i = 0; i < 4; ++i) { const int idx = tid + 512 * i, s = idx >> 4, cg8 = (idx & 15) * 8;
            float f[8]; unpack8(*(const u32x4*)(P + (size_t)(r0 + s) * NPROJ + C_V + g * 128 + cg8), f); const float rs = rstd[s];
#pragma unroll
            for (int j = 0; j < 8; ++j) VT[(cg8 + j) * 136 + s] = f2bf(f[j] * rs * gn[cg8 + j]); }
    }
    __syncthreads();
    {
        f32x4 acc[8];
#pragma unroll
        for (int c = 0; c < 8; ++c) acc[c] = (f32x4){0.f, 0.f, 0.f, 0.f};
        const int nks = (wave >> 1) + 1;
        for (int ks = 0; ks < nks; ++ks) {
            const bf16x8 af = *(const bf16x8*)(WsA + (wave * 16 + l15) * 136 + ks * 32 + q * 8);
#pragma unroll
            for (int c = 0; c < 8; ++c) { const bf16x8 bfr = *(const bf16x8*)(VT + (c * 16 + l15) * 136 + ks * 32 + q * 8); acc[c] = __builtin_amdgcn_mfma_f32_16x16x32_bf16(af, bfr, acc[c], 0, 0, 0); }
        }
        const float* bs = a.in[8] + ((size_t)l * 8 + g) * 128;
#pragma unroll
        for (int j = 0; j < 4; ++j) { const int t = wave * 16 + q * 4 + j; const float b = bs[t];
#pragma unroll
            for (int c = 0; c < 8; ++c) MIX[t * 132 + c * 16 + l15] = acc[c][j] + b; }
    }
    __syncthreads();
#pragma unroll
    for (int i = 0; i < 4; ++i) { const int idx = tid + 512 * i, t = idx >> 4, cg8 = (idx & 15) * 8; const size_t pr = (size_t)(r0 + t) * NPROJ + g * 128 + cg8;
        float u[8], z[8]; unpack8(*(const u32x4*)(P + pr + C_U), u); unpack8(*(const u32x4*)(P + pr + C_Z), z);
        const f32x4 m0 = *(const f32x4*)(MIX + t * 132 + cg8), m1 = *(const f32x4*)(MIX + t * 132 + cg8 + 4);
        u32x4 o; o.x = pk2(u[0] * m0[0] * silu(z[0]), u[1] * m0[1] * silu(z[1])); o.y = pk2(u[2] * m0[2] * silu(z[2]), u[3] * m0[3] * silu(z[3]));
        o.z = pk2(u[4] * m1[0] * silu(z[4]), u[5] * m1[1] * silu(z[5])); o.w = pk2(u[6] * m1[2] * silu(z[6]), u[7] * m1[3] * silu(z[7]));
        *(u32x4*)(YA + (size_t)(r0 + t) * D + g * 128 + cg8) = o; }
    __syncthreads();
}
__device__ __forceinline__ void task_gmlp_sample(const Args& a, int l, int task, int tid) {
    asm volatile("" : "+v"(tid));
    const int wave = tid >> 6, lane = tid & 63; const int b = task * 8 + wave, r = TP + b;
    const bf16_t* P = (const bf16_t*)(a.ws + WS_PROJ); bf16_t* YA = (bf16_t*)(a.ws + WS_YA);
    const size_t pr = (size_t)r * NPROJ;
    float v[16]; unpack8(*(const u32x4*)(P + pr + C_V + lane * 16), v); unpack8(*(const u32x4*)(P + pr + C_V + lane * 16 + 8), v + 8);
    float s = 0.f;
#pragma unroll
    for (int j = 0; j < 16; ++j) s += v[j] * v[j];
    const float rs = rsqrtf(wave_sum(s) * (1.f / D) + EPS);
    const int g = lane >> 3;
    const float w00 = a.in[7][((size_t)l * 8 + g) * 128 * 128], b0 = a.in[8][((size_t)l * 8 + g) * 128];
    const float* gn = a.in[6] + (size_t)l * D + lane * 16;
    float u[16], z[16]; unpack8(*(const u32x4*)(P + pr + C_U + lane * 16), u); unpack8(*(const u32x4*)(P + pr + C_U + lane * 16 + 8), u + 8);
    unpack8(*(const u32x4*)(P + pr + C_Z + lane * 16), z); unpack8(*(const u32x4*)(P + pr + C_Z + lane * 16 + 8), z + 8);
    float* vo = a.out + O_VS + ((size_t)l * DB + b) * D + lane * 16; float y[16];
#pragma unroll
    for (int j = 0; j < 16; ++j) { const float vn = v[j] * rs * gn[j]; vo[j] = vn; y[j] = u[j] * (w00 * vn + b0) * silu(z[j]); }
    u32x4 o0, o1; o0.x = pk2(y[0], y[1]); o0.y = pk2(y[2], y[3]); o0.z = pk2(y[4], y[5]); o0.w = pk2(y[6], y[7]);
    o1.x = pk2(y[8], y[9]); o1.y = pk2(y[10], y[11]); o1.z = pk2(y[12], y[13]); o1.w = pk2(y[14], y[15]);
    *(u32x4*)(YA + (size_t)r * D + lane * 16) = o0; *(u32x4*)(YA + (size_t)r * D + lane * 16 + 8) = o1;
}
__device__ __forceinline__ void task_delta_sample(const Args& a, int l, unsigned char* lds, int task, int tid) {
    asm volatile("" : "+v"(tid));
    const int b = task >> 3, h = task & 7, r = TP + b; const int wave = tid >> 6, lane = tid & 63;
    const bf16_t* P = (const bf16_t*)(a.ws + WS_PROJ); const float* AB = (const float*)(a.ws + WS_AB); bf16_t* YB = (bf16_t*)(a.ws + WS_YB);
    float* qkv = (float*)lds;
    float* sc = qkv + 384;
    float* part = qkv + 512;
    float* red = part + 1024;
    if (tid < 384) {
        const int tz = tid >> 7, ch = tid & 127, col = tz * 1024 + h * 128 + ch;
        const float* cw = a.in[9] + (size_t)l * 4 * CONVD + col; const float* sb = a.in[3] + ((size_t)l * DB + b) * 3 * CONVD + col;
        const float xn = bf1(P[(size_t)r * NPROJ + C_QKV + col]);
        const float x0 = sb[0], x1 = sb[CONVD], x2 = sb[2 * CONVD];
        qkv[tid] = silu(cw[0] * x0 + cw[CONVD] * x1 + cw[2 * CONVD] * x2 + cw[3 * CONVD] * xn);
        if (h == 0 || true) { float* co = a.out + O_CS + ((size_t)l * DB + b) * 3 * CONVD + col; co[0] = x1; co[CONVD] = x2; co[2 * CONVD] = xn; }
    }
    __syncthreads();
    if (wave < 3) {
        const float q0 = qkv[lane], q1 = qkv[64 + lane], k0 = qkv[128 + lane], k1 = qkv[192 + lane];
        float s = (wave == 0) ? q0 * q0 + q1 * q1 : (wave == 1 ? k0 * k0 + k1 * k1 : q0 * k0 + q1 * k1);
        s = wave_sum(s);
        if (lane == 0) sc[wave] = s;
    }
    __syncthreads();
    const float qs = rsqrtf(sc[0] + EPS) * 0.08838834764831845f, ks = rsqrtf(sc[1] + EPS), qk = sc[2] * qs * ks;
    const float av = AB[(size_t)r * 16 + h], bv = AB[(size_t)r * 16 + 8 + h];
    const float xs = av + a.in[11][l * 8 + h]; const float sp = (xs > 20.f) ? xs : log1pf(__expf(xs));
    const float gg = -__expf(a.in[10][l * 8 + h]) * sp, eg = __expf(gg), beta = sigm(bv);
    const int vc = tid & 127, kq = tid >> 7;
    const float* S = a.in[2] + (((size_t)l * DB + b) * 8 + h) * 16384 + (size_t)(kq * 32) * 128 + vc;
    float Sr[32]; float pk = 0.f, pq = 0.f;
#pragma unroll
    for (int i = 0; i < 32; ++i) { Sr[i] = S[i * 128]; const float kn = qkv[128 + kq * 32 + i] * ks, qn = qkv[kq * 32 + i] * qs; pk += kn * Sr[i]; pq += qn * Sr[i]; }
    part[kq * 128 + vc] = pk; part[512 + kq * 128 + vc] = pq;
    __syncthreads();
    const float kS = part[vc] + part[128 + vc] + part[256 + vc] + part[384 + vc], qS = part[512 + vc] + part[640 + vc] + part[768 + vc] + part[896 + vc];
    const float vnew = beta * (qkv[256 + vc] - eg * kS), o = eg * qS + qk * vnew;
    float* So = a.out + O_GS + (((size_t)l * DB + b) * 8 + h) * 16384 + (size_t)(kq * 32) * 128 + vc;
#pragma unroll
    for (int i = 0; i < 32; ++i) So[i * 128] = eg * Sr[i] + qkv[128 + kq * 32 + i] * ks * vnew;
    if (kq == 0) { const float s = wave_sum(o * o); if (lane == 0) red[wave] = s; }
    __syncthreads();
    if (kq == 0) {
        const float rs = rsqrtf((red[0] + red[1]) * (1.f / 128.f) + EPS);
        const float zb = bf1(P[(size_t)r * NPROJ + C_ZB + h * 128 + vc]);
        YB[(size_t)r * D + h * 128 + vc] = f2bf(o * rs * a.in[12][l * 128 + vc] * silu(zb));
    }
    __syncthreads();
}
__device__ __forceinline__ bf16x8 ld8f_bf16(const float* p) { const f32x4 x = *(const f32x4*)p, y = *(const f32x4*)(p + 4); u32x4 w; w.x = pk2(x[0], x[1]); w.y = pk2(x[2], x[3]); w.z = pk2(y[0], y[1]); w.w = pk2(y[2], y[3]); return as_bf16x8(w); }
__device__ __forceinline__ void task_prep(const Args& a, int l, unsigned char* lds, int task, int tid) {
    asm volatile("" : "+v"(tid));
    const int n = task & 31, h = (task >> 5) & 7, b = task >> 8; const int wave = tid >> 6, lane = tid & 63, l15 = lane & 15, q = lane >> 4;
    const bf16_t* P = (const bf16_t*)(a.ws + WS_PROJ); const float* AB = (const float*)(a.ws + WS_AB);
    unsigned char* rec = a.ws + WS_REC + (size_t)task * REC_BYTES;
    float* Qs = (float*)lds; float* Ks = Qs + 64 * 132; float* Vs = Ks + 64 * 132; float* TTm = Vs + 64 * 132;
    float* gc = TTm + 64 * 68; float* beta = gc + 64; float* eg = beta + 64;
    const int tok0 = b * SEQ + n * 64;
#pragma unroll 2
    for (int i = 0; i < 6; ++i) {
        const int idx = tid + 512 * i, cg8 = (idx & 15) * 8, row = (idx >> 4) & 63, tz = idx >> 10; const int col = tz * 1024 + h * 128 + cg8; const int tpos = n * 64 + row;
        const float* cw = a.in[9] + (size_t)l * 4 * CONVD + col;
        float acc[8];
#pragma unroll
        for (int j = 0; j < 8; ++j) acc[j] = 0.f;
#pragma unroll
        for (int ii = 0; ii < 4; ++ii) { const int tp = tpos - 3 + ii;
            if (tp >= 0) { float x[8]; unpack8(*(const u32x4*)(P + (size_t)(b * SEQ + tp) * NPROJ + C_QKV + col), x); const f32x4 w0 = *(const f32x4*)(cw + ii * CONVD), w1 = *(const f32x4*)(cw + ii * CONVD + 4);
#pragma unroll
                for (int j = 0; j < 4; ++j) { acc[j] += w0[j] * x[j]; acc[4 + j] += w1[j] * x[4 + j]; } } }
        float* dst = Qs + tz * (64 * 132) + row * 132 + cg8;
        *(f32x4*)dst = (f32x4){silu(acc[0]), silu(acc[1]), silu(acc[2]), silu(acc[3])}; *(f32x4*)(dst + 4) = (f32x4){silu(acc[4]), silu(acc[5]), silu(acc[6]), silu(acc[7])};
    }
    __syncthreads();
    {
        const int rowid = tid >> 2, part = tid & 3; float* p = Qs + (rowid >> 6) * (64 * 132) + (rowid & 63) * 132 + part * 32;
        f32x4 v[8]; float s = 0.f;
#pragma unroll
        for (int i = 0; i < 8; ++i) { v[i] = *(const f32x4*)(p + 4 * i); s += (v[i][0] * v[i][0] + v[i][1] * v[i][1]) + (v[i][2] * v[i][2] + v[i][3] * v[i][3]); }
        s += __shfl_xor(s, 1); s += __shfl_xor(s, 2);
        const float scl = rsqrtf(s + EPS) * ((rowid < 64) ? 0.08838834764831845f : 1.0f);
#pragma unroll
        for (int i = 0; i < 8; ++i) *(f32x4*)(p + 4 * i) = v[i] * scl;
    }
    if (tid < 64) {
        const float av = AB[(size_t)(tok0 + tid) * 16 + h], bv = AB[(size_t)(tok0 + tid) * 16 + 8 + h];
        const float xs = av + a.in[11][l * 8 + h]; const float sp = (xs > 20.f) ? xs : log1pf(__expf(xs));
        float g = -__expf(a.in[10][l * 8 + h]) * sp;
#pragma unroll
        for (int o = 1; o < 64; o <<= 1) { const float t = __shfl_up(g, o); if (lane >= o) g += t; }
        gc[tid] = g; beta[tid] = sigm(bv); eg[tid] = __expf(g);
        if (tid == 63) ((float*)(a.ws + WS_GL))[task] = __expf(g);
    }
    __syncthreads();
    {
        const int isq = wave >> 2, it = wave & 3; const float* Asrc = isq ? Qs : Ks;
        f32x4 acc[4];
#pragma unroll
        for (int j = 0; j < 4; ++j) acc[j] = (f32x4){0.f, 0.f, 0.f, 0.f};
#pragma unroll
        for (int ks = 0; ks < 4; ++ks) { const bf16x8 af = ld8f_bf16(Asrc + (it * 16 + l15) * 132 + ks * 32 + q * 8);
#pragma unroll
            for (int jt = 0; jt < 4; ++jt) if (jt <= it) { const bf16x8 bfr = ld8f_bf16(Ks + (jt * 16 + l15) * 132 + ks * 32 + q * 8); acc[jt] = __builtin_amdgcn_mfma_f32_16x16x32_bf16(af, bfr, acc[jt], 0, 0, 0); } }
        bf16_t* ATT = (bf16_t*)(rec + REC_ATT);
#pragma unroll
        for (int jt = 0; jt < 4; ++jt)
#pragma unroll
            for (int jj = 0; jj < 4; ++jj) { const int i = it * 16 + q * 4 + jj, j = jt * 16 + l15; const float dg = gc[i] - gc[j];
                if (isq) { const float v = (j <= i) ? acc[jt][jj] * __expf(dg) : 0.f; ATT[i * 64 + j] = f2bf(v); }
                else if (j < i) TTm[j * 68 + i] = beta[i] * acc[jt][jj] * __expf(dg); }
    }
    __syncthreads();
    if (tid < 256) {
        const int c = tid; float r[64]; int vz = 0; asm volatile("" : "+v"(vz)); const float* TTv = TTm + vz; const float* betav = beta + vz; const float* egv = eg + vz;
        if (c < 128) {
#pragma unroll
            for (int i = 0; i < 64; ++i) r[i] = Vs[i * 132 + c] * betav[i];
        } else {
#pragma unroll
            for (int i = 0; i < 64; ++i) r[i] = Ks[i * 132 + c - 128] * betav[i] * egv[i];
        }
#pragma unroll
        for (int j = 0; j < 63; ++j) { const float xj = r[j];
#pragma unroll
            for (int i4 = ((j + 1) & ~3); i4 < 64; i4 += 4) { const f32x4 t4 = *(const f32x4*)(TTv + j * 68 + i4);
#pragma unroll
                for (int e = 0; e < 4; ++e) if (i4 + e > j) r[i4 + e] -= t4[e] * xj; } }
        if (c < 128) { float* UT = (float*)(rec + REC_UT) + c * 64;
#pragma unroll
            for (int i = 0; i < 16; ++i) *(f32x4*)(UT + 4 * i) = (f32x4){r[4 * i], r[4 * i + 1], r[4 * i + 2], r[4 * i + 3]};
        } else { bf16_t* W = (bf16_t*)(rec + REC_W) + (c - 128);
#pragma unroll
            for (int i = 0; i < 64; ++i) W[i * 128] = f2bf(-r[i]); }
    } else {
        const int t2 = tid - 256; bf16_t* QD = (bf16_t*)(rec + REC_QD); bf16_t* KDT = (bf16_t*)(rec + REC_KDT); const float gl = gc[63];
#pragma unroll
        for (int i = 0; i < 4; ++i) { const int item = t2 + 256 * i, t = item >> 4, cg8 = (item & 15) * 8; const float e = eg[t]; const float* s = Qs + t * 132 + cg8;
            const f32x4 x = *(const f32x4*)s, y = *(const f32x4*)(s + 4); u32x4 w; w.x = pk2(x[0] * e, x[1] * e); w.y = pk2(x[2] * e, x[3] * e); w.z = pk2(y[0] * e, y[1] * e); w.w = pk2(y[2] * e, y[3] * e);
            *(u32x4*)(QD + t * 128 + cg8) = w; }
#pragma unroll
        for (int i = 0; i < 4; ++i) { const int item = t2 + 256 * i, d = item & 127, tg = item >> 7; float v[8];
#pragma unroll
            for (int jj = 0; jj < 8; ++jj) v[jj] = Ks[(tg * 8 + jj) * 132 + d] * __expf(gl - gc[tg * 8 + jj]);
            u32x4 w; w.x = pk2(v[0], v[1]); w.y = pk2(v[2], v[3]); w.z = pk2(v[4], v[5]); w.w = pk2(v[6], v[7]);
            *(u32x4*)(KDT + d * 64 + tg * 8) = w; }
    }
    __syncthreads();
}
__device__ __forceinline__ void task_scan(const Args& a, int l, unsigned char* lds, int task, int tid) {
    asm volatile("" : "+v"(tid));
    const int h = task & 7, b = task >> 3; const int wave = tid >> 6, lane = tid & 63, l15 = lane & 15, q = lane >> 4;
    const int rt = wave & 3, cb = (wave >> 2) * 4;
    const bf16_t* P = (const bf16_t*)(a.ws + WS_PROJ); bf16_t* YB = (bf16_t*)(a.ws + WS_YB); const float* GL = (const float*)(a.ws + WS_GL);
    bf16_t* ST0 = (bf16_t*)lds; bf16_t* ST1 = (bf16_t*)(lds + 34816); bf16_t* VT = (bf16_t*)(lds + 2 * 34816); float* RED = (float*)(lds + 2 * 34816 + 18432);
    for (int i = tid; i < 34816 / 16; i += NTHR) ((u32x4*)ST0)[i] = (u32x4){0u, 0u, 0u, 0u};
    f32x4 accS[8];
#pragma unroll
    for (int c = 0; c < 8; ++c) accS[c] = (f32x4){0.f, 0.f, 0.f, 0.f};
    const float* gdn = a.in[12] + l * 128;
    __syncthreads();
#pragma unroll 1
    for (int n = 0; n < 32; ++n) {
        const int ctask = task * 32 + n; const unsigned char* rec = a.ws + WS_REC + (size_t)ctask * REC_BYTES;
        const bf16_t* STc = (n & 1) ? ST1 : ST0; bf16_t* STn = (n & 1) ? ST0 : ST1;
        const bf16_t* Wn = (const bf16_t*)(rec + REC_W); const bf16_t* QD = (const bf16_t*)(rec + REC_QD); const bf16_t* ATT = (const bf16_t*)(rec + REC_ATT);
        const bf16_t* KDT = (const bf16_t*)(rec + REC_KDT); const float* UT = (const float*)(rec + REC_UT);
        bf16x8 aw[4], aq[4], aat[2], ak[2]; f32x4 accP[4];
#pragma unroll
        for (int ks = 0; ks < 4; ++ks) { aw[ks] = *(const bf16x8*)(Wn + (rt * 16 + l15) * 128 + ks * 32 + q * 8); aq[ks] = *(const bf16x8*)(QD + (rt * 16 + l15) * 128 + ks * 32 + q * 8); }
#pragma unroll
        for (int ks = 0; ks < 2; ++ks) { aat[ks] = *(const bf16x8*)(ATT + (rt * 16 + l15) * 64 + ks * 32 + q * 8); ak[ks] = *(const bf16x8*)(KDT + (wave * 16 + l15) * 64 + ks * 32 + q * 8); }
#pragma unroll
        for (int t = 0; t < 4; ++t) accP[t] = *(const f32x4*)(UT + ((cb + t) * 16 + l15) * 64 + rt * 16 + q * 4);
        const float gl = GL[ctask];
#pragma unroll
        for (int t = 0; t < 4; ++t) {
#pragma unroll
            for (int ks = 0; ks < 4; ++ks) { const bf16x8 bfr = *(const bf16x8*)(STc + ((cb + t) * 16 + l15) * 136 + ks * 32 + q * 8); accP[t] = __builtin_amdgcn_mfma_f32_16x16x32_bf16(aw[ks], bfr, accP[t], 0, 0, 0); }
            u32x2 w; w.x = pk2(accP[t][0], accP[t][1]); w.y = pk2(accP[t][2], accP[t][3]);
            *(u32x2*)(VT + ((cb + t) * 16 + l15) * 72 + rt * 16 + q * 4) = w;
        }
        __syncthreads();
        f32x4 accO[4];
#pragma unroll
        for (int t = 0; t < 4; ++t) { accO[t] = (f32x4){0.f, 0.f, 0.f, 0.f};
#pragma unroll
            for (int ks = 0; ks < 4; ++ks) { const bf16x8 bfr = *(const bf16x8*)(STc + ((cb + t) * 16 + l15) * 136 + ks * 32 + q * 8); accO[t] = __builtin_amdgcn_mfma_f32_16x16x32_bf16(aq[ks], bfr, accO[t], 0, 0, 0); }
#pragma unroll
            for (int ks = 0; ks < 2; ++ks) { const bf16x8 bfr = *(const bf16x8*)(VT + ((cb + t) * 16 + l15) * 72 + ks * 32 + q * 8); accO[t] = __builtin_amdgcn_mfma_f32_16x16x32_bf16(aat[ks], bfr, accO[t], 0, 0, 0); } }
        {
            float s[4];
#pragma unroll
            for (int jj = 0; jj < 4; ++jj) { s[jj] = (accO[0][jj] * accO[0][jj] + accO[1][jj] * accO[1][jj]) + (accO[2][jj] * accO[2][jj] + accO[3][jj] * accO[3][jj]);
                s[jj] += __shfl_xor(s[jj], 1); s[jj] += __shfl_xor(s[jj], 2); s[jj] += __shfl_xor(s[jj], 4); s[jj] += __shfl_xor(s[jj], 8); }
            if (l15 == 0) *(f32x4*)(RED + (wave >> 2) * 64 + rt * 16 + q * 4) = (f32x4){s[0], s[1], s[2], s[3]};
        }
#pragma unroll
        for (int c = 0; c < 8; ++c) { accS[c] = accS[c] * gl;
#pragma unroll
            for (int ks = 0; ks < 2; ++ks) { const bf16x8 bfr = *(const bf16x8*)(VT + (c * 16 + l15) * 72 + ks * 32 + q * 8); accS[c] = __builtin_amdgcn_mfma_f32_16x16x32_bf16(ak[ks], bfr, accS[c], 0, 0, 0); }
            u32x2 w; w.x = pk2(accS[c][0], accS[c][1]); w.y = pk2(accS[c][2], accS[c][3]);
            *(u32x2*)(STn + (c * 16 + l15) * 136 + wave * 16 + q * 4) = w; }
        __syncthreads();
        {
            const f32x4 r0 = *(const f32x4*)(RED + rt * 16 + q * 4), r1 = *(const f32x4*)(RED + 64 + rt * 16 + q * 4);
#pragma unroll
            for (int jj = 0; jj < 4; ++jj) { const float rs = rsqrtf((r0[jj] + r1[jj]) * (1.f / 128.f) + EPS); const size_t tok = (size_t)b * SEQ + n * 64 + rt * 16 + q * 4 + jj;
#pragma unroll
                for (int t = 0; t < 4; ++t) { const int col = (cb + t) * 16 + l15; const float zb = bf1(P[tok * NPROJ + C_ZB + h * 128 + col]);
                    YB[tok * D + h * 128 + col] = f2bf(accO[t][jj] * rs * gdn[col] * silu(zb)); } }
        }
    }
    float* So = a.out + O_GP + (((size_t)l * NB + b) * 8 + h) * 16384;
#pragma unroll
    for (int c = 0; c < 8; ++c)
#pragma unroll
        for (int jj = 0; jj < 4; ++jj) So[(wave * 16 + q * 4 + jj) * 128 + c * 16 + l15] = accS[c][jj];
    __syncthreads();
}
__device__ __forceinline__ void task_conv_state_prompt(const Args& a, int l, int tid) {
    asm volatile("" : "+v"(tid));
    const bf16_t* P = (const bf16_t*)(a.ws + WS_PROJ);
    for (int i = tid; i < NB * 3 * CONVD; i += NTHR) { const int c = i % CONVD, r = (i / CONVD) % 3, b = i / (3 * CONVD);
        a.out[O_CP + (size_t)l * NB * 3 * CONVD + i] = bf1(P[(size_t)(b * SEQ + SEQ - 3 + r) * NPROJ + C_QKV + c]); }
}
__global__ void __launch_bounds__(NTHR) mega_fwd(Args a) {
    extern __shared__ __attribute__((aligned(16))) unsigned char lds[];
    cg::grid_group grid = cg::this_grid();
    const int tid = threadIdx.x, wg = blockIdx.x, G = gridDim.x;
    bf16_t* H = (bf16_t*)(a.ws + WS_H); bf16_t* PROJ = (bf16_t*)(a.ws + WS_PROJ); float* AB = (float*)(a.ws + WS_AB);
    bf16_t* YA = (bf16_t*)(a.ws + WS_YA); bf16_t* YB = (bf16_t*)(a.ws + WS_YB); float* TMP = (float*)(a.ws + WS_TMP); bf16_t* MG = (bf16_t*)(a.ws + WS_MERGED);
    #ifndef NO_P0
    phase_prologue(a, lds, wg, G, tid);
#endif
    grid.sync();
#pragma unroll 1
    for (int l = 0; l < DEPTH; ++l) {
#ifndef NO_P1
        {
            pg8::Gemm g{H, (const bf16_t*)(a.ws + WS_W1T) + (size_t)l * NW1 * D, MP, NW1, D}; pg8::StaticOrder S; S.init(MP, NW1, G, wg);
            Epi1 E{PROJ, AB}; pg8::gemm_phase<Epi1, pg8::StaticOrder>((LAS unsigned char*)lds, g, S, E, nullptr);
        }
#endif
        grid.sync();
#ifndef NO_P2
        for (int t = wg; t < NB * 8 * 32; t += G) task_prep(a, l, lds, t, tid);
#endif
        grid.sync();
        {
#ifndef NO_SCAN
            for (int t = wg; t < 64; t += G) task_scan(a, l, lds, t, tid);
#endif
            const int o = (G > 64) ? wg - 64 : wg, stride = (G > 64) ? G - 64 : G;
#ifndef NO_P3O
            if (o >= 0) {
                constexpr int N_DS = DB * 8, N_GP = 1024, N_GS = DB / 8, N_ALL = N_DS + N_GP + N_GS + 1;
                for (int it = o; it < N_ALL; it += stride) {
                    if (it < N_DS) task_delta_sample(a, l, lds, it, tid);
                    else if (it < N_DS + N_GP) task_gmlp_prompt(a, l, lds, it - N_DS, tid);
                    else if (it < N_DS + N_GP + N_GS) task_gmlp_sample(a, l, it - N_DS - N_GP, tid);
                    else task_conv_state_prompt(a, l, tid);
                }
            }
#endif
        }
        grid.sync();
#ifndef NO_P4
        {
            pg8::StaticOrder S; S.init(MP, D, G, wg);
            { pg8::Gemm g{YA, (const bf16_t*)(a.ws + WS_WPA) + (size_t)l * D * D, MP, D, D}; Epi2a E{PROJ, TMP}; pg8::gemm_phase<Epi2a, pg8::StaticOrder>((LAS unsigned char*)lds, g, S, E, nullptr); }
            { pg8::Gemm g{YB, (const bf16_t*)(a.ws + WS_WPB) + (size_t)l * D * D, MP, D, D}; Epi2b E{PROJ, TMP, MG}; pg8::gemm_phase<Epi2b, pg8::StaticOrder>((LAS unsigned char*)lds, g, S, E, nullptr); }
        }
#endif
        grid.sync();
#ifndef NO_P5
        {
            pg8::StaticOrder S; S.init(MP, D, G, wg);
            pg8::Gemm g{MG, (const bf16_t*)(a.ws + WS_WOUT) + (size_t)l * D * D, MP, D, D}; Epi3 E{TMP}; pg8::gemm_phase<Epi3, pg8::StaticOrder>((LAS unsigned char*)lds, g, S, E, nullptr);
        }
#endif
        grid.sync();
#ifndef NO_P6
        phase_residual(a, l, wg, G, tid);
#endif
        grid.sync();
    }
}
extern "C" void kernel_launch(void* const* d_in, const int* in_sizes, int n_in, void* d_out, int out_size, void* d_ws, size_t ws_size, hipStream_t stream) {
    static int grid = 0;
    if (grid == 0) {
        int dev = 0, cus = 0, per_cu = 0;
        hipGetDevice(&dev); hipDeviceGetAttribute(&cus, hipDeviceAttributeMultiprocessorCount, dev);
        if (hipFuncSetAttribute((const void*)mega_fwd, hipFuncAttributeMaxDynamicSharedMemorySize, LDS_BYTES) != hipSuccess) fprintf(stderr, "hipFuncSetAttribute failed\n");
        if (hipOccupancyMaxActiveBlocksPerMultiprocessor(&per_cu, (const void*)mega_fwd, NTHR, LDS_BYTES) != hipSuccess || per_cu < 1) { fprintf(stderr, "occupancy query: %d\n", per_cu); per_cu = 1; }
        (void)hipGetLastError();
        grid = cus;
        if (ws_size < WS_END) { fprintf(stderr, "workspace too small: %zu < %zu\n", ws_size, (size_t)WS_END); grid = -1; }
    }
    if (grid < 0) return;
    Args a{};
    for (int i = 0; i < 17; ++i) a.in[i] = (const float*)d_in[i];
    a.out = (float*)d_out; a.ws = (unsigned char*)d_ws;
    void* args[] = {&a};
    hipError_t e = hipLaunchCooperativeKernel((const void*)mega_fwd, dim3(grid), dim3(NTHR), args, LDS_BYTES, stream);
    if (e != hipSuccess) fprintf(stderr, "cooperative launch failed: %s (grid %d)\n", hipGetErrorString(e), grid);
}
```

```cpp
#include <hip/hip_runtime.h>
#include <hip/hip_cooperative_groups.h>
#include <cstdio>
namespace cg = cooperative_groups;
namespace pg8 {
#define PG8_LAS __attribute__((address_space(3)))
typedef unsigned short bf16_t;
typedef short bf16x8 __attribute__((ext_vector_type(8)));
typedef float f32x4 __attribute__((ext_vector_type(4)));
typedef unsigned u32x4 __attribute__((ext_vector_type(4)));
constexpr int BM = 256, BK = 64, HALF = 128, HTB = HALF * BK * 2  , STAGE_BYTES = 8 * HTB, NXCD = 8, WGM = 8;

__host__ __device__ __forceinline__ int lds_byte(int r, int c) { const int st = (r >> 4) * 2 + (c >> 5), rr = r & 15, cc = c & 31, ob = rr * 64 + cc * 2; return st * 1024 + (ob ^ (((ob >> 9) & 1) << 5)); }
__host__ __device__ __forceinline__ void stage_rc(int b, int& R, int& C) { const int st = b / 1024, sb = b % 1024, swz = sb ^ (((sb >> 9) & 1) << 5); R = (st >> 1) * 16 + swz / 64; C = (st & 1) * 32 + (swz % 64) / 2; }
__host__ __device__ __forceinline__ int perm32(int rho) { const int n = rho >> 4, i = rho & 15; return 8 * (i >> 2) + 4 * n + (i & 3); }

struct Unit { int pm, pn; };
struct Gemm { const bf16_t* A; const bf16_t* Bt; int M, N, K; };

struct StaticOrder {
    int nM, nN, nwg, G, c;
    __host__ __device__ void init(int M, int N, int G_, int c_) { nM = M / BM; nN = N / BM; nwg = nM * nN; G = G_; c = c_; }
    __host__ __device__ bool next(int i, Unit& u) const {
        const long L = (long)i * G + c; if (L >= nwg) return false;
        int wgid = (int)L; { const int q = nwg / NXCD, r = nwg % NXCD, xcd = wgid % NXCD, off = wgid / NXCD; wgid = (xcd < r ? xcd * (q + 1) : r * (q + 1) + (xcd - r) * q) + off; }
        const int nig = WGM * nN, gid = wgid / nig, fm = gid * WGM, gsz = (nM - fm) < WGM ? (nM - fm) : WGM;
        u.pm = fm + ((wgid % nig) % gsz); u.pn = (wgid % nig) / gsz; return true;
    }
    __device__ __forceinline__ void a_ready(const Unit&) const {}
    __device__ __forceinline__ void done(const Unit&) const {}
};
typedef float f32x2c __attribute__((ext_vector_type(2))); typedef __bf16 bf16x2c __attribute__((ext_vector_type(2)));
__device__ __forceinline__ unsigned cvt_pk_bf16(float lo, float hi) { const f32x2c v = {lo, hi}; const bf16x2c r = __builtin_convertvector(v, bf16x2c); return __builtin_bit_cast(unsigned, r); }
template <class Epi, class Sched, bool STAMP = false>
__device__ __forceinline__ void gemm_phase(PG8_LAS unsigned char* lds, const Gemm g, const Sched& S, const Epi& E, unsigned long long* stamps) {
    int tid_opq = threadIdx.x; asm volatile("" : "+v"(tid_opq));
    const int tid = tid_opq, wid = __builtin_amdgcn_readfirstlane(tid >> 6), lane = tid & 63, wr = wid >> 2, wc = wid & 3, fr = lane & 15, fq = lane >> 4;
    const int K = g.K, nt = K / BK;
    int ts_lo = 0, ts_hi = 0, nts = 0; const unsigned long long rt_entry = STAMP ? (unsigned long long)wall_clock64() : 0ull;
#define PG8_STAMP() do { if (STAMP && wid == 0 && nts < 64) { const unsigned long long _c = (unsigned long long)clock64(); \
        ts_lo = (lane == nts) ? (int)(unsigned)_c : ts_lo; ts_hi = (lane == nts) ? (int)(unsigned)(_c >> 32) : ts_hi; ++nts; } } while (0)
    PG8_STAMP();
    unsigned voffA[2], voffB[2];
#pragma unroll
    for (int i = 0; i < 2; ++i) { int R, C; stage_rc(tid * 16 + i * 8192, R, C); const int Rb = Epi::PERM ? ((R & ~31) + perm32(R & 31)) : R;
        voffA[i] = (unsigned)(R * K + C) * 2u; voffB[i] = (unsigned)(Rb * K + C) * 2u; }
    const size_t kstep = (size_t)(BK * 2);
    const size_t hstep = (size_t)HALF * K * 2;
    const size_t tstep = 2 * hstep;
    const unsigned ldsw = (unsigned)wid * 1024u;
    const int aoff = lds_byte(wr * 64 + fr, fq * 8), boff = lds_byte(wc * 32 + fr, fq * 8);
#define PG8_SA(b, h) (((b) * 2 + (h)) * HTB)
#define PG8_SB(b, h) ((4 + (b) * 2 + (h)) * HTB)
#define PG8_STAGE(bufoff, gbase, voff) do { _Pragma("unroll") for (int _i = 0; _i < 2; ++_i) \
        __builtin_amdgcn_global_load_lds((const unsigned*)((const char*)(gbase) + (voff)[_i]), (PG8_LAS unsigned*)(lds + (bufoff) + ldsw + _i * 8192), 16, 0, 0); } while (0)
#define PG8_LDA(dst, b, h) do { _Pragma("unroll") for (int m = 0; m < 4; ++m) _Pragma("unroll") for (int k = 0; k < 2; ++k) dst[m][k] = *(const PG8_LAS bf16x8*)(lds + PG8_SA(b, h) + aoff + m * 2048 + k * 1024); } while (0)
#define PG8_LDB(dst, b, h) do { _Pragma("unroll") for (int n = 0; n < 2; ++n) _Pragma("unroll") for (int k = 0; k < 2; ++k) dst[n][k] = *(const PG8_LAS bf16x8*)(lds + PG8_SB(b, h) + boff + n * 2048 + k * 1024); } while (0)
#define PG8_MMA(ai, bj, At, Bt) do { __builtin_amdgcn_s_setprio(1); _Pragma("unroll") for (int m = 0; m < 4; ++m) _Pragma("unroll") for (int n = 0; n < 2; ++n) _Pragma("unroll") for (int k = 0; k < 2; ++k) \
        acc[ai][bj][m][n] = __builtin_amdgcn_mfma_f32_16x16x32_bf16(Bt[n][k], At[m][k], acc[ai][bj][m][n], 0, 0, 0); __builtin_amdgcn_s_setprio(0); } while (0)
#define PG8_WAIT_V(n) asm volatile("s_waitcnt vmcnt(" #n ")" ::: "memory")
#define PG8_WAIT_L(n) asm volatile("s_waitcnt lgkmcnt(" #n ")" ::: "memory")
#define PG8_BAR __builtin_amdgcn_s_barrier()
#define PG8_SCHED __builtin_amdgcn_sched_barrier(0)
    Unit cur, nxt; int ui = 0;
    if (!S.next(0, cur)) return;
    f32x4 acc[2][2][4][2];
#pragma unroll
    for (int a = 0; a < 2; ++a)
#pragma unroll
        for (int b = 0; b < 2; ++b)
#pragma unroll
            for (int m = 0; m < 4; ++m)
#pragma unroll
                for (int n = 0; n < 2; ++n) acc[a][b][m][n] = (f32x4){0.f, 0.f, 0.f, 0.f};
    bf16x8 At[4][2], B0[2][2], B1[2][2];
    const char* cA = (const char*)g.A + (size_t)cur.pm * tstep; const char* cB = (const char*)g.Bt + (size_t)cur.pn * tstep;
    S.a_ready(cur);
    PG8_STAGE(PG8_SB(0, 0), cB, voffB); PG8_STAGE(PG8_SA(0, 0), cA, voffA); PG8_STAGE(PG8_SB(0, 1), cB + hstep, voffB); PG8_STAGE(PG8_SA(0, 1), cA + hstep, voffA);
    if (wr == 1) PG8_BAR;
    PG8_WAIT_V(4); PG8_BAR;
    PG8_STAGE(PG8_SB(1, 0), cB + kstep, voffB); PG8_STAGE(PG8_SA(1, 0), cA + kstep, voffA); PG8_STAGE(PG8_SB(1, 1), cB + hstep + kstep, voffB);
    PG8_WAIT_V(6); PG8_BAR;
    PG8_STAMP();
    for (;;) {
        const bool has_next = S.next(ui + 1, nxt);
        const char* nA = has_next ? (const char*)g.A + (size_t)nxt.pm * tstep : cA; const char* nB = has_next ? (const char*)g.Bt + (size_t)nxt.pn * tstep : cB;
        for (int t = 0; t < nt; t += 2) {
            const bool last = (t == nt - 2);
            const char* a1 = cA + (size_t)(t + 1) * kstep;
            const char* a2 = last ? nA : cA + (size_t)(t + 2) * kstep; const char* b2 = last ? nB : cB + (size_t)(t + 2) * kstep;
            const char* a3 = a2 + kstep; const char* b3 = b2 + kstep;
            if (last && has_next) S.a_ready(nxt);
            PG8_LDB(B0, 0, 0); PG8_SCHED; PG8_LDA(At, 0, 0); PG8_STAGE(PG8_SA(1, 1), a1 + hstep, voffA);
            PG8_WAIT_L(8); PG8_BAR; PG8_WAIT_L(0); PG8_MMA(0, 0, At, B0); PG8_BAR; PG8_SCHED;
            PG8_LDB(B1, 0, 1); PG8_STAGE(PG8_SB(0, 0), b2, voffB);
            PG8_BAR; PG8_WAIT_L(0); PG8_MMA(0, 1, At, B1); PG8_BAR;
            PG8_LDA(At, 0, 1); PG8_STAGE(PG8_SA(0, 0), a2, voffA);
            PG8_BAR; PG8_WAIT_L(0); PG8_MMA(1, 0, At, B0); PG8_BAR; PG8_SCHED;
            PG8_STAGE(PG8_SB(0, 1), b2 + hstep, voffB);
            PG8_WAIT_V(6); PG8_BAR; PG8_MMA(1, 1, At, B1); PG8_BAR;
            PG8_LDB(B0, 1, 0); PG8_SCHED; PG8_LDA(At, 1, 0); PG8_STAGE(PG8_SA(0, 1), a2 + hstep, voffA);
            PG8_WAIT_L(8); PG8_BAR; PG8_WAIT_L(0); PG8_MMA(0, 0, At, B0); PG8_BAR; PG8_SCHED;
            PG8_LDB(B1, 1, 1); PG8_STAGE(PG8_SB(1, 0), b3, voffB);
            PG8_BAR; PG8_WAIT_L(0); PG8_MMA(0, 1, At, B1); PG8_BAR;
            PG8_LDA(At, 1, 1); PG8_STAGE(PG8_SA(1, 0), a3, voffA);
            PG8_BAR; PG8_WAIT_L(0); PG8_MMA(1, 0, At, B0); PG8_BAR; PG8_SCHED;
            PG8_STAGE(PG8_SB(1, 1), b3 + hstep, voffB);
            PG8_WAIT_V(6); PG8_BAR; PG8_MMA(1, 1, At, B1); PG8_BAR;
        }
        PG8_STAMP();
        if constexpr (!Epi::AFTER_DRAIN) { E(acc, cur, wr, wc, fr, fq); S.done(cur); }
        PG8_STAMP();
        if (!has_next) break;
        bool zero_acc = true;
        if constexpr (Epi::KEEP) zero_acc = !E.keep(cur);
        if (zero_acc) {
#pragma unroll
        for (int a = 0; a < 2; ++a)
#pragma unroll
            for (int b = 0; b < 2; ++b)
#pragma unroll
                for (int m = 0; m < 4; ++m)
#pragma unroll
                    for (int n = 0; n < 2; ++n) acc[a][b][m][n] = (f32x4){0.f, 0.f, 0.f, 0.f};
        }
        cur = nxt; cA = nA; cB = nB; ++ui;
    }
    PG8_WAIT_V(0);
    if (wr == 0) PG8_BAR;
    PG8_BAR;
    if constexpr (Epi::AFTER_DRAIN) { E.fused(acc, cur, wr, wc, fr, fq, lds, wid, lane); S.done(cur); }
    PG8_STAMP();
    if (STAMP && wid == 0) { stamps[lane] = lane < nts ? (((unsigned long long)(unsigned)ts_hi << 32) | (unsigned)ts_lo) : 0ull;
        if (lane == 62) stamps[62] = rt_entry; if (lane == 63) stamps[63] = (unsigned long long)wall_clock64(); }
#undef PG8_STAMP
#undef PG8_SA
#undef PG8_SB
#undef PG8_STAGE
#undef PG8_LDA
#undef PG8_LDB
#undef PG8_MMA
#undef PG8_WAIT_V
#undef PG8_WAIT_L
#undef PG8_BAR
#undef PG8_SCHED
}
}
using pg8::bf16_t; using pg8::bf16x8; using pg8::f32x4; using pg8::u32x4; using pg8::Unit;
typedef unsigned u32x2 __attribute__((ext_vector_type(2)));
#define LAS __attribute__((address_space(3)))

constexpr int D = 1024, NB = 8, SEQ = 2048, DEPTH = 4, DB = 128, TP = NB * SEQ, TT = TP + DB, MP = 16640;
constexpr int INDIM = 9232, NPROJ = 9216, NW1 = 9472, CONVD = 3072;
constexpr int C_U = 0, C_V = 1024, C_Z = 2048, C_QKV = 3072, C_ZB = 6144, C_GA = 7168, C_GB = 8192;
constexpr float EPS = 1e-6f;
constexpr int NTHR = 512;
constexpr int LDS_BYTES = 147456;
constexpr size_t MiB = 1u << 20;
constexpr size_t WS_RSTDV = 512 * 1024;
constexpr size_t WS_W1T = 1 * MiB, WS_WPA = 75 * MiB, WS_WPB = 83 * MiB, WS_WOUT = 91 * MiB, WS_H = 99 * MiB, WS_PROJ = 132 * MiB,
                 WS_AB = 425 * MiB, WS_YA = 427 * MiB, WS_YB = 460 * MiB, WS_REC = 493 * MiB, WS_TMP = 493 * MiB, WS_MERGED = 560 * MiB,
                 WS_TMP2 = 594 * MiB, WS_XB = 637 * MiB, WS_GL = 670 * MiB, WS_END = 671 * MiB;
constexpr int REC_BYTES = 73728, REC_W = 0, REC_QD = 16384, REC_ATT = 32768, REC_KDT = 40960, REC_UT = 57344;
constexpr size_t O_Y = 0, O_GP = 16908288, O_CP = 21102592, O_GS = 21397504, O_CS = 88506368, O_VS = 93224960;

struct Args { const float* in[17]; float* out; unsigned char* ws; };

__device__ __forceinline__ float sigm(float x) { return __builtin_amdgcn_rcpf(1.0f + __expf(-x)); }
__device__ __forceinline__ float silu(float x) { return x * sigm(x); }
__device__ __forceinline__ unsigned pk2(float lo, float hi) { return pg8::cvt_pk_bf16(lo, hi); }
__device__ __forceinline__ float bflo(unsigned w) { return __uint_as_float(w << 16); }
__device__ __forceinline__ float bfhi(unsigned w) { return __uint_as_float(w & 0xffff0000u); }
__device__ __forceinline__ float bf1(bf16_t b) { return __uint_as_float((unsigned)b << 16); }
__device__ __forceinline__ bf16_t f2bf(float f) { return (bf16_t)(pk2(f, 0.f) & 0xffffu); }
__device__ __forceinline__ void unpack8(const u32x4 w, float* f) { f[0] = bflo(w.x); f[1] = bfhi(w.x); f[2] = bflo(w.y); f[3] = bfhi(w.y); f[4] = bflo(w.z); f[5] = bfhi(w.z); f[6] = bflo(w.w); f[7] = bfhi(w.w); }
__device__ __forceinline__ float wave_sum(float v) {
#pragma unroll
    for (int o = 1; o < 64; o <<= 1) v += __shfl_xor(v, o);
    return v;
}
__device__ __forceinline__ bf16x8 as_bf16x8(u32x4 w) { return __builtin_bit_cast(bf16x8, w); }

#define SCHED_FENCE() __builtin_amdgcn_sched_barrier(0)
#define LDS_BAR() do { asm volatile("s_waitcnt lgkmcnt(0)" ::: "memory"); __builtin_amdgcn_s_barrier(); asm volatile("" ::: "memory"); } while (0)
struct Epi1 {
    static constexpr bool PERM = true, AFTER_DRAIN = false, KEEP = false;
    bf16_t* P; float* AB;
    __device__ __forceinline__ void operator()(const f32x4 (&acc)[2][2][4][2], const Unit& u, int wr, int wc, int fr, int fq) const {
        const int row0 = u.pm * 256 + wr * 64 + fr;
        if (u.pn < 36) {
            const int col0 = u.pn * 256 + wc * 32 + 8 * fq;
#pragma unroll
            for (int ai = 0; ai < 2; ++ai)
#pragma unroll
                for (int m = 0; m < 4; ++m) { bf16_t* rowp = P + (size_t)(row0 + ai * 128 + m * 16) * NPROJ + col0;
#pragma unroll
                    for (int bj = 0; bj < 2; ++bj) { const f32x4 v0 = acc[ai][bj][m][0], v1 = acc[ai][bj][m][1];
                        u32x4 w; w.x = pk2(v0[0], v0[1]); w.y = pk2(v0[2], v0[3]); w.z = pk2(v1[0], v1[1]); w.w = pk2(v1[2], v1[3]);
                        *(u32x4*)(rowp + bj * 128) = w; } }
        } else if (wc == 0 && fq < 2) {
#pragma unroll
            for (int ai = 0; ai < 2; ++ai)
#pragma unroll
                for (int m = 0; m < 4; ++m) { float* rp = AB + (size_t)(row0 + ai * 128 + m * 16) * 16 + 8 * fq;
                    *(f32x4*)rp = acc[ai][0][m][0]; *(f32x4*)(rp + 4) = acc[ai][0][m][1]; }
        }
    }
};
constexpr int P4_DPM = (int)((WS_YB - WS_YA) / (256 * 2048)), P4_DPN = (int)((WS_WPB - WS_WPA) / (256 * 2048));
static_assert((WS_YB - WS_YA) % (256 * 2048) == 0 && (WS_WPB - WS_WPA) % (256 * 2048) == 0, "tile-aligned operand offsets");
struct PairOrder : pg8::StaticOrder {
    __device__ bool next(int i, Unit& u) const {
        if (i >= 2) return false;
        if (!pg8::StaticOrder::next(0, u)) return false;
        if (i == 1) { u.pm += P4_DPM; u.pn += P4_DPN; }
        return true;
    }
};
struct Epi2ab {
    static constexpr bool PERM = true, AFTER_DRAIN = false, KEEP = true;
    const bf16_t* P; bf16_t* MG;
    __device__ __forceinline__ bool keep(const Unit& u) const { return u.pm < P4_DPM; }
    __device__ __forceinline__ void operator()(f32x4 (&acc)[2][2][4][2], const Unit& u, int wr, int wc, int fr, int fq) const {
        if (u.pm < P4_DPM) {
            const int row0 = u.pm * 256 + wr * 64 + fr, col0 = u.pn * 256 + wc * 32 + 8 * fq;
#pragma unroll
            for (int ai = 0; ai < 2; ++ai) {
                u32x4 ga[4][2], gb[4][2];
#pragma unroll
                for (int m = 0; m < 4; ++m)
#pragma unroll
                    for (int bj = 0; bj < 2; ++bj) { const size_t r = (size_t)(row0 + ai * 128 + m * 16); ga[m][bj] = *(const u32x4*)(P + r * NPROJ + C_GA + col0 + bj * 128); gb[m][bj] = *(const u32x4*)(P + r * NPROJ + C_GB + col0 + bj * 128); }
#pragma unroll
                for (int m = 0; m < 4; ++m)
#pragma unroll
                    for (int bj = 0; bj < 2; ++bj) { float a8[8], b8[8]; unpack8(ga[m][bj], a8); unpack8(gb[m][bj], b8);
#pragma unroll
                        for (int j = 0; j < 4; ++j) {
                            acc[ai][bj][m][0][j] *= (1.0f + __expf(-fmaxf(b8[j], -30.f))) * __builtin_amdgcn_rcpf(1.0f + __expf(-a8[j]));
                            acc[ai][bj][m][1][j] *= (1.0f + __expf(-fmaxf(b8[4 + j], -30.f))) * __builtin_amdgcn_rcpf(1.0f + __expf(-a8[4 + j])); } }
            }
        } else {
            const int row0 = (u.pm - P4_DPM) * 256 + wr * 64 + fr, col0 = (u.pn - P4_DPN) * 256 + wc * 32 + 8 * fq;
#pragma unroll
            for (int ai = 0; ai < 2; ++ai) {
                u32x4 gb[4][2];
#pragma unroll
                for (int m = 0; m < 4; ++m)
#pragma unroll
                    for (int bj = 0; bj < 2; ++bj) gb[m][bj] = *(const u32x4*)(P + (size_t)(row0 + ai * 128 + m * 16) * NPROJ + C_GB + col0 + bj * 128);
#pragma unroll
                for (int m = 0; m < 4; ++m) { const size_t r = (size_t)(row0 + ai * 128 + m * 16);
#pragma unroll
                    for (int bj = 0; bj < 2; ++bj) { float b8[8]; unpack8(gb[m][bj], b8); float sb[8];
#pragma unroll
                        for (int j = 0; j < 8; ++j) sb[j] = __builtin_amdgcn_rcpf(1.0f + __expf(-fmaxf(b8[j], -30.f)));
                        const f32x4 v0 = acc[ai][bj][m][0], v1 = acc[ai][bj][m][1];
                        u32x4 w; w.x = pk2(v0[0] * sb[0], v0[1] * sb[1]); w.y = pk2(v0[2] * sb[2], v0[3] * sb[3]); w.z = pk2(v1[0] * sb[4], v1[1] * sb[5]); w.w = pk2(v1[2] * sb[6], v1[3] * sb[7]);
                        *(u32x4*)(MG + r * D + col0 + bj * 128) = w; } }
            }
        }
    }
};
struct Epi3 {
    static constexpr bool PERM = true, AFTER_DRAIN = false, KEEP = false;
    bf16_t* C;
    __device__ __forceinline__ void operator()(const f32x4 (&acc)[2][2][4][2], const Unit& u, int wr, int wc, int fr, int fq) const {
        const int row0 = u.pm * 256 + wr * 64 + fr, col0 = u.pn * 256 + wc * 32 + 8 * fq;
#pragma unroll
        for (int ai = 0; ai < 2; ++ai)
#pragma unroll
            for (int m = 0; m < 4; ++m) { bf16_t* rowp = C + (size_t)(row0 + ai * 128 + m * 16) * D + col0;
#pragma unroll
                for (int bj = 0; bj < 2; ++bj) { const f32x4 v0 = acc[ai][bj][m][0], v1 = acc[ai][bj][m][1];
                    u32x4 w; w.x = pk2(v0[0], v0[1]); w.y = pk2(v0[2], v0[3]); w.z = pk2(v1[0], v1[1]); w.w = pk2(v1[2], v1[3]);
                    *(u32x4*)(rowp + bj * 128) = w; } }
    }
};
__device__ __forceinline__ void p0_transpose_item(const float* W, int nsrc, bf16_t* WT, float* scr, int item, int nblk, int lane, int mode) {
    const int kb = item / nblk, nb = item % nblk, k0 = 64 * kb, n0 = 64 * nb;
    const int n = n0 + (lane & 15) * 4;
    int sc = n;
    if (mode == 1) sc = (n < 7168) ? n : (n < 9216 ? n + 16 : (n < 9232 ? n - 9216 + 7168 : -1));
    {
        f32x4 wv[16];
#pragma unroll
        for (int i = 0; i < 16; ++i) { const int kk = 4 * i + (lane >> 4); wv[i] = (sc >= 0) ? *(const f32x4*)(W + (size_t)(k0 + kk) * nsrc + sc) : (f32x4){0.f, 0.f, 0.f, 0.f}; }
        SCHED_FENCE();
#pragma unroll
        for (int i = 0; i < 16; ++i) { const int kk = 4 * i + (lane >> 4); float* d = scr + kk * 65 + (lane & 15) * 4; d[0] = wv[i][0]; d[1] = wv[i][1]; d[2] = wv[i][2]; d[3] = wv[i][3]; }
    }
    asm volatile("s_waitcnt lgkmcnt(0)" ::: "memory");
    const int c = lane & 7;
#pragma unroll
    for (int j = 0; j < 8; ++j) { const int nn = (lane >> 3) + 8 * j; const float* s = scr + (8 * c) * 65 + nn;
        u32x4 o; o.x = pk2(s[0 * 65], s[1 * 65]); o.y = pk2(s[2 * 65], s[3 * 65]); o.z = pk2(s[4 * 65], s[5 * 65]); o.w = pk2(s[6 * 65], s[7 * 65]);
        *(u32x4*)(WT + (size_t)(n0 + nn) * 1024 + k0 + 8 * c) = o; }
    asm volatile("s_waitcnt lgkmcnt(0)" ::: "memory");
}
__device__ __forceinline__ void rms_row_to_bf16(const float* xrow, const float* g, bf16_t* orow, int lane) {
    const f32x4* xr = (const f32x4*)xrow + lane; const f32x4* gr = (const f32x4*)g + lane;
    f32x4 v[4]; float s = 0.f;
#pragma unroll
    for (int j = 0; j < 4; ++j) { v[j] = xr[64 * j]; s += (v[j][0] * v[j][0] + v[j][1] * v[j][1]) + (v[j][2] * v[j][2] + v[j][3] * v[j][3]); }
    const float rstd = rsqrtf(wave_sum(s) * (1.f / D) + EPS);
    u32x2* o8 = (u32x2*)orow + lane;
#pragma unroll
    for (int j = 0; j < 4; ++j) { const f32x4 gg = gr[64 * j]; u32x2 w; w.x = pk2(v[j][0] * rstd * gg[0], v[j][1] * rstd * gg[1]); w.y = pk2(v[j][2] * rstd * gg[2], v[j][3] * rstd * gg[3]); o8[64 * j] = w; }
}
__device__ __forceinline__ void phase_weights(const Args& a, unsigned char* lds, int lw, int wgi, int nwg, int tid) {
    asm volatile("" : "+v"(tid));
    const int wave = tid >> 6, lane = tid & 63; const int gw = wgi * 8 + wave, NGW = nwg * 8;
    float* scr = (float*)(lds + wave * 16640);
    constexpr int I_IN = 16 * (NW1 / 64), I_SQ = 16 * 16, PER_L = I_IN + 3 * I_SQ;
    for (int it = gw; it < PER_L; it += NGW) {
        const int l = lw; int r = it;
        if (r < I_IN) { p0_transpose_item(a.in[5] + (size_t)l * D * INDIM, INDIM, (bf16_t*)(a.ws + WS_W1T) + (size_t)l * NW1 * D, scr, r, NW1 / 64, lane, 1); continue; } r -= I_IN;
        if (r < I_SQ) { p0_transpose_item(a.in[13] + (size_t)l * D * D, D, (bf16_t*)(a.ws + WS_WPA) + (size_t)l * D * D, scr, r, 16, lane, 0); continue; } r -= I_SQ;
        if (r < I_SQ) { p0_transpose_item(a.in[14] + (size_t)l * D * D, D, (bf16_t*)(a.ws + WS_WPB) + (size_t)l * D * D, scr, r, 16, lane, 0); continue; } r -= I_SQ;
        p0_transpose_item(a.in[15] + (size_t)l * D * D, D, (bf16_t*)(a.ws + WS_WOUT) + (size_t)l * D * D, scr, r, 16, lane, 0);
    }
}
__device__ __forceinline__ void phase_prologue(const Args& a, unsigned char* lds, int wg, int G, int tid) {
    asm volatile("" : "+v"(tid));
    const int wave = tid >> 6, lane = tid & 63; const int gw = wg * 8 + wave, NGW = G * 8;
    phase_weights(a, lds, 0, wg, G, tid);
    bf16_t* H = (bf16_t*)(a.ws + WS_H);
    for (int m = gw; m < MP; m += NGW) {
        if (m < TT) { const float* xr = (m < TP) ? a.in[0] + (size_t)m * D : a.in[1] + (size_t)(m - TP) * D; rms_row_to_bf16(xr, a.in[4], H + (size_t)m * D, lane); }
        else { u32x4 z = {0u, 0u, 0u, 0u}; u32x4* o = (u32x4*)(H + (size_t)m * D) + lane; o[0] = z; o[64] = z; }
    }
}
__device__ __forceinline__ void phase_residual(const Args& a, int l, int wg, int G, int tid) {
    asm volatile("" : "+v"(tid));
    const int wave = tid >> 6, lane = tid & 63; const int gw = wg * 8 + wave, NGW = G * 8;
    const bf16_t* OUT = (const bf16_t*)(a.ws + WS_TMP); bf16_t* H = (bf16_t*)(a.ws + WS_H); bf16_t* XB = (bf16_t*)(a.ws + WS_XB);
    const f32x4* pgp = (const f32x4*)(a.in[16] + (size_t)l * D) + lane;
    const f32x4* ngp = (const f32x4*)(a.in[4] + (size_t)((l + 1 < DEPTH) ? l + 1 : l) * D) + lane;
    f32x4 pg[4], ng[4];
#pragma unroll
    for (int j = 0; j < 4; ++j) { pg[j] = pgp[64 * j]; ng[j] = ngp[64 * j]; }
    for (int m0 = gw; m0 < TT; m0 += 2 * NGW) {
        f32x4 v[2][4], x[2][4]; float s[2], s2[2];
#pragma unroll
        for (int r = 0; r < 2; ++r) { const int m = (m0 + r * NGW < TT) ? m0 + r * NGW : m0;
            const u32x2* orow = (const u32x2*)(OUT + (size_t)m * D) + lane;
#pragma unroll
            for (int j = 0; j < 4; ++j) { const u32x2 ow = orow[64 * j]; v[r][j] = (f32x4){bflo(ow.x), bfhi(ow.x), bflo(ow.y), bfhi(ow.y)}; }
            if (l == 0) { const float* xs = (m < TP) ? a.in[0] + (size_t)m * D : a.in[1] + (size_t)(m - TP) * D; const f32x4* xr = (const f32x4*)xs + lane;
#pragma unroll
                for (int j = 0; j < 4; ++j) x[r][j] = xr[64 * j];
            } else { const u32x2* xr = (const u32x2*)(XB + (size_t)m * D) + lane;
#pragma unroll
                for (int j = 0; j < 4; ++j) { const u32x2 xw = xr[64 * j]; x[r][j] = (f32x4){bflo(xw.x), bfhi(xw.x), bflo(xw.y), bfhi(xw.y)}; } } }
#pragma unroll
        for (int r = 0; r < 2; ++r) { s[r] = 0.f;
#pragma unroll
            for (int j = 0; j < 4; ++j) s[r] += (v[r][j][0] * v[r][j][0] + v[r][j][1] * v[r][j][1]) + (v[r][j][2] * v[r][j][2] + v[r][j][3] * v[r][j][3]); }
#pragma unroll
        for (int o = 1; o < 64; o <<= 1) { s[0] += __shfl_xor(s[0], o); s[1] += __shfl_xor(s[1], o); }
#pragma unroll
        for (int r = 0; r < 2; ++r) { const float rs = rsqrtf(s[r] * (1.f / D) + EPS); s2[r] = 0.f;
#pragma unroll
            for (int j = 0; j < 4; ++j) { const f32x4 g = pg[j]; x[r][j] = x[r][j] + v[r][j] * rs * g; s2[r] += (x[r][j][0] * x[r][j][0] + x[r][j][1] * x[r][j][1]) + (x[r][j][2] * x[r][j][2] + x[r][j][3] * x[r][j][3]); } }
#pragma unroll
        for (int o = 1; o < 64; o <<= 1) { s2[0] += __shfl_xor(s2[0], o); s2[1] += __shfl_xor(s2[1], o); }
#pragma unroll
        for (int r = 0; r < 2; ++r) { const int m = m0 + r * NGW;
            if (m < TT) {
                if (l + 1 == DEPTH) { f32x4* xo = (f32x4*)(a.out + O_Y + (size_t)m * D) + lane;
#pragma unroll
                    for (int j = 0; j < 4; ++j) xo[64 * j] = x[r][j];
                } else { u32x2* xo = (u32x2*)(XB + (size_t)m * D) + lane;
#pragma unroll
                    for (int j = 0; j < 4; ++j) { u32x2 w; w.x = pk2(x[r][j][0], x[r][j][1]); w.y = pk2(x[r][j][2], x[r][j][3]); xo[64 * j] = w; } }
                if (l + 1 < DEPTH) { const float r2 = rsqrtf(s2[r] * (1.f / D) + EPS); u32x2* o8 = (u32x2*)(H + (size_t)m * D) + lane;
#pragma unroll
                    for (int j = 0; j < 4; ++j) { const f32x4 g = ng[j]; u32x2 w; w.x = pk2(x[r][j][0] * r2 * g[0], x[r][j][1] * r2 * g[1]); w.y = pk2(x[r][j][2] * r2 * g[2], x[r][j][3] * r2 * g[3]); o8[64 * j] = w; } }
            } }
    }
}
__device__ __forceinline__ void phase_vrstd(const Args& a, int wg, int G, int tid) {
    asm volatile("" : "+v"(tid));
    const int wave = tid >> 6, lane = tid & 63; const bf16_t* P = (const bf16_t*)(a.ws + WS_PROJ); float* R = (float*)(a.ws + WS_RSTDV);
    for (int m = wg * 8 + wave; m < TP; m += G * 8) {
        const u32x4* vp = (const u32x4*)(P + (size_t)m * NPROJ + C_V) + lane; float f[8], s = 0.f;
        unpack8(vp[0], f);
#pragma unroll
        for (int j = 0; j < 8; ++j) s += f[j] * f[j];
        unpack8(vp[64], f);
#pragma unroll
        for (int j = 0; j < 8; ++j) s += f[j] * f[j];
        s = wave_sum(s);
        if (lane == 0) R[m] = rsqrtf(s * (1.f / D) + EPS);
    }
}
__device__ __forceinline__ void task_gmlp_prompt(const Args& a, int l, unsigned char* lds, int task, int tid) {
    asm volatile("" : "+v"(tid));
    const int chunk = task >> 3, g = task & 7, r0 = chunk * 128;
    const int wave = tid >> 6, lane = tid & 63, l15 = lane & 15, q = lane >> 4;
    const bf16_t* P = (const bf16_t*)(a.ws + WS_PROJ); bf16_t* YA = (bf16_t*)(a.ws + WS_YA); const float* R = (const float*)(a.ws + WS_RSTDV);
    bf16_t* WsA = (bf16_t*)(lds + 1024);
    bf16_t* VT = (bf16_t*)(lds + 1024 + 34816);
    float* MIX = (float*)(lds + 1024 + 2 * 34816);
    const int it_ = tid >> 4, icg8 = (tid & 15) * 8;
    const float* Ws = a.in[7] + ((size_t)l * 8 + g) * 128 * 128;
    f32x4 wv[8]; u32x4 vv[4], uu[4], zz[4]; float rs[4];
#pragma unroll
    for (int i = 0; i < 8; ++i) { const int idx = tid + 512 * i; wv[i] = *(const f32x4*)(Ws + (idx >> 5) * 128 + (idx & 31) * 4); }
#pragma unroll
    for (int i = 0; i < 4; ++i) { const size_t pr = (size_t)(r0 + it_ + 32 * i) * NPROJ + g * 128 + icg8;
        vv[i] = *(const u32x4*)(P + pr + C_V); uu[i] = *(const u32x4*)(P + pr + C_U); zz[i] = *(const u32x4*)(P + pr + C_Z); rs[i] = R[r0 + it_ + 32 * i]; }
    float gn[8];
#pragma unroll
    for (int j = 0; j < 8; ++j) gn[j] = a.in[6][(size_t)l * D + g * 128 + icg8 + j];
#pragma unroll
    for (int i = 0; i < 8; ++i) { const int idx = tid + 512 * i, t = idx >> 5, s4 = (idx & 31) * 4; const f32x4 w = wv[i];
        u32x2 o; o.x = pk2(s4 <= t ? w[0] : 0.f, s4 + 1 <= t ? w[1] : 0.f); o.y = pk2(s4 + 2 <= t ? w[2] : 0.f, s4 + 3 <= t ? w[3] : 0.f);
        *(u32x2*)(WsA + t * 136 + s4) = o; }
#pragma unroll
    for (int i = 0; i < 4; ++i) { const int sidx = it_ + 32 * i; float f[8]; unpack8(vv[i], f); const int sw = sidx ^ icg8;
#pragma unroll
        for (int j = 0; j < 8; ++j) VT[(icg8 + j) * 136 + sw] = f2bf(f[j] * rs[i] * gn[j]); }
    LDS_BAR();
    {
        f32x4 acc[8];
#pragma unroll
        for (int c = 0; c < 8; ++c) acc[c] = (f32x4){0.f, 0.f, 0.f, 0.f};
        const int nks = (wave >> 1) + 1;
        for (int ks = 0; ks < nks; ++ks) {
            const bf16x8 af = *(const bf16x8*)(WsA + (wave * 16 + l15) * 136 + ks * 32 + q * 8); bf16x8 bfr[8];
#pragma unroll
            for (int c = 0; c < 8; ++c) { const int cc = c * 16 + l15; bfr[c] = *(const bf16x8*)(VT + cc * 136 + ((ks * 32 + q * 8) ^ ((cc >> 3) * 8))); }
            SCHED_FENCE();
#pragma unroll
            for (int c = 0; c < 8; ++c) acc[c] = __builtin_amdgcn_mfma_f32_16x16x32_bf16(af, bfr[c], acc[c], 0, 0, 0);
            SCHED_FENCE();
        }
        const float* bs = a.in[8] + ((size_t)l * 8 + g) * 128;
#pragma unroll
        for (int j = 0; j < 4; ++j) { const int t = wave * 16 + q * 4 + j; const float b = bs[t];
#pragma unroll
            for (int c = 0; c < 8; ++c) MIX[t * 132 + c * 16 + l15] = acc[c][j] + b; }
    }
    LDS_BAR();
#pragma unroll
    for (int i = 0; i < 4; ++i) { const int t = it_ + 32 * i;
        float u[8], z[8]; unpack8(uu[i], u); unpack8(zz[i], z);
        const f32x4 m0 = *(const f32x4*)(MIX + t * 132 + icg8), m1 = *(const f32x4*)(MIX + t * 132 + icg8 + 4);
        u32x4 o; o.x = pk2(u[0] * m0[0] * silu(z[0]), u[1] * m0[1] * silu(z[1])); o.y = pk2(u[2] * m0[2] * silu(z[2]), u[3] * m0[3] * silu(z[3]));
        o.z = pk2(u[4] * m1[0] * silu(z[4]), u[5] * m1[1] * silu(z[5])); o.w = pk2(u[6] * m1[2] * silu(z[6]), u[7] * m1[3] * silu(z[7]));
        *(u32x4*)(YA + (size_t)(r0 + t) * D + g * 128 + icg8) = o; }
    LDS_BAR();
}
__device__ __forceinline__ void task_gmlp_sample(const Args& a, int l, int task, int tid) {
    asm volatile("" : "+v"(tid));
    const int wave = tid >> 6, lane = tid & 63; const int b = task * 8 + wave, r = TP + b;
    const bf16_t* P = (const bf16_t*)(a.ws + WS_PROJ); bf16_t* YA = (bf16_t*)(a.ws + WS_YA);
    const size_t pr = (size_t)r * NPROJ;
    float v[16]; unpack8(*(const u32x4*)(P + pr + C_V + lane * 16), v); unpack8(*(const u32x4*)(P + pr + C_V + lane * 16 + 8), v + 8);
    float s = 0.f;
#pragma unroll
    for (int j = 0; j < 16; ++j) s += v[j] * v[j];
    const float rs = rsqrtf(wave_sum(s) * (1.f / D) + EPS);
    const int g = lane >> 3;
    const float w00 = a.in[7][((size_t)l * 8 + g) * 128 * 128], b0 = a.in[8][((size_t)l * 8 + g) * 128];
    const float* gn = a.in[6] + (size_t)l * D + lane * 16;
    float u[16], z[16]; unpack8(*(const u32x4*)(P + pr + C_U + lane * 16), u); unpack8(*(const u32x4*)(P + pr + C_U + lane * 16 + 8), u + 8);
    unpack8(*(const u32x4*)(P + pr + C_Z + lane * 16), z); unpack8(*(const u32x4*)(P + pr + C_Z + lane * 16 + 8), z + 8);
    float* vo = a.out + O_VS + ((size_t)l * DB + b) * D + lane * 16; float y[16];
#pragma unroll
    for (int j = 0; j < 16; ++j) { const float vn = v[j] * rs * gn[j]; vo[j] = vn; y[j] = u[j] * (w00 * vn + b0) * silu(z[j]); }
    u32x4 o0, o1; o0.x = pk2(y[0], y[1]); o0.y = pk2(y[2], y[3]); o0.z = pk2(y[4], y[5]); o0.w = pk2(y[6], y[7]);
    o1.x = pk2(y[8], y[9]); o1.y = pk2(y[10], y[11]); o1.z = pk2(y[12], y[13]); o1.w = pk2(y[14], y[15]);
    *(u32x4*)(YA + (size_t)r * D + lane * 16) = o0; *(u32x4*)(YA + (size_t)r * D + lane * 16 + 8) = o1;
}
__device__ __forceinline__ void task_delta_sample(const Args& a, int l, unsigned char* lds, int task, int tid) {
    asm volatile("" : "+v"(tid));
    const int b = task >> 3, h = task & 7, r = TP + b; const int wave = tid >> 6, lane = tid & 63;
    const bf16_t* P = (const bf16_t*)(a.ws + WS_PROJ); const float* AB = (const float*)(a.ws + WS_AB); bf16_t* YB = (bf16_t*)(a.ws + WS_YB);
    float* qkv = (float*)lds;
    float* sc = qkv + 384;
    float* part = qkv + 512;
    float* red = part + 1024;
    const int vc = tid & 127, kq = tid >> 7;
    const float* S = a.in[2] + (((size_t)l * DB + b) * 8 + h) * 16384 + (size_t)(kq * 32) * 128 + vc;
    float Sr[32];
#pragma unroll
    for (int i = 0; i < 32; ++i) Sr[i] = S[i * 128];
    const float av = AB[(size_t)r * 16 + h], bv = AB[(size_t)r * 16 + 8 + h];
    const float zb = bf1(P[(size_t)r * NPROJ + C_ZB + h * 128 + vc]);
    if (tid < 384) {
        const int tz = tid >> 7, ch = tid & 127, col = tz * 1024 + h * 128 + ch;
        const float* cw = a.in[9] + (size_t)l * 4 * CONVD + col; const float* sb = a.in[3] + ((size_t)l * DB + b) * 3 * CONVD + col;
        const float xn = bf1(P[(size_t)r * NPROJ + C_QKV + col]);
        const float x0 = sb[0], x1 = sb[CONVD], x2 = sb[2 * CONVD];
        qkv[tid] = silu(cw[0] * x0 + cw[CONVD] * x1 + cw[2 * CONVD] * x2 + cw[3 * CONVD] * xn);
        float* co = a.out + O_CS + ((size_t)l * DB + b) * 3 * CONVD + col; co[0] = x1; co[CONVD] = x2; co[2 * CONVD] = xn;
    }
    LDS_BAR();
    if (wave < 3) {
        const float q0 = qkv[lane], q1 = qkv[64 + lane], k0 = qkv[128 + lane], k1 = qkv[192 + lane];
        float s = (wave == 0) ? q0 * q0 + q1 * q1 : (wave == 1 ? k0 * k0 + k1 * k1 : q0 * k0 + q1 * k1);
        s = wave_sum(s);
        if (lane == 0) sc[wave] = s;
    }
    LDS_BAR();
    const float qs = rsqrtf(sc[0] + EPS) * 0.08838834764831845f, ks = rsqrtf(sc[1] + EPS), qk = sc[2] * qs * ks;
    const float xs = av + a.in[11][l * 8 + h]; const float sp = (xs > 20.f) ? xs : log1pf(__expf(xs));
    const float gg = -__expf(a.in[10][l * 8 + h]) * sp, eg = __expf(gg), beta = sigm(bv);
    float pk = 0.f, pq = 0.f;
#pragma unroll
    for (int i = 0; i < 32; ++i) { const float kn = qkv[128 + kq * 32 + i] * ks, qn = qkv[kq * 32 + i] * qs; pk += kn * Sr[i]; pq += qn * Sr[i]; }
    part[kq * 128 + vc] = pk; part[512 + kq * 128 + vc] = pq;
    LDS_BAR();
    const float kS = part[vc] + part[128 + vc] + part[256 + vc] + part[384 + vc], qS = part[512 + vc] + part[640 + vc] + part[768 + vc] + part[896 + vc];
    const float vnew = beta * (qkv[256 + vc] - eg * kS), o = eg * qS + qk * vnew;
    float* So = a.out + O_GS + (((size_t)l * DB + b) * 8 + h) * 16384 + (size_t)(kq * 32) * 128 + vc;
#pragma unroll
    for (int i = 0; i < 32; ++i) So[i * 128] = eg * Sr[i] + qkv[128 + kq * 32 + i] * ks * vnew;
    if (kq == 0) { const float s = wave_sum(o * o); if (lane == 0) red[wave] = s; }
    LDS_BAR();
    if (kq == 0) {
        const float rs = rsqrtf((red[0] + red[1]) * (1.f / 128.f) + EPS);
        YB[(size_t)r * D + h * 128 + vc] = f2bf(o * rs * a.in[12][l * 128 + vc] * silu(zb));
    }
    LDS_BAR();
}
__device__ __forceinline__ void task_prep2(const Args& a, int l, unsigned char* lds, int task, int tid) {
    asm volatile("" : "+v"(tid));
    typedef float f32x2 __attribute__((ext_vector_type(2)));
    const int p = task & 15, h = (task >> 4) & 7, b = task >> 7; const int wave = tid >> 6, lane = tid & 63, l15 = lane & 15, q = lane >> 4;
    const bf16_t* P = (const bf16_t*)(a.ws + WS_PROJ); const float* AB = (const float*)(a.ws + WS_AB);
    const int ctask0 = (b * 8 + h) * 32 + 2 * p;
    bf16_t* Qb = (bf16_t*)lds; bf16_t* Kb = Qb + 128 * 136; bf16_t* Vb = Kb + 128 * 136;
    float* TTm = (float*)(lds + 104448);
    float* gc = (float*)(lds + 139264); float* beta = gc + 128; float* eg = beta + 128;
    const int tok0 = b * SEQ + p * 128;
    float av = 0.f, bv = 0.f;
    if (tid < 128) { av = AB[(size_t)(tok0 + tid) * 16 + h]; bv = AB[(size_t)(tok0 + tid) * 16 + 8 + h]; }
#pragma unroll 1
    for (int half = 0; half < 2; ++half) {
        if (tid < 384) {
            const int tz = tid >> 7, cg8 = (tid & 15) * 8, rb = (tid >> 4) & 7; const int col = tz * 1024 + h * 128 + cg8;
            const float* cw = a.in[9] + (size_t)l * 4 * CONVD + col;
            u32x4 xr[11];
#pragma unroll
            for (int k = 0; k < 11; ++k) { const int tp = p * 128 + half * 64 + rb * 8 - 3 + k;
                xr[k] = (tp >= 0) ? *(const u32x4*)(P + (size_t)(b * SEQ + tp) * NPROJ + C_QKV + col) : (u32x4){0u, 0u, 0u, 0u}; }
            f32x4 w0[4], w1[4];
#pragma unroll
            for (int ii = 0; ii < 4; ++ii) { w0[ii] = *(const f32x4*)(cw + ii * CONVD); w1[ii] = *(const f32x4*)(cw + ii * CONVD + 4); }
#pragma unroll
            for (int rr = 0; rr < 8; ++rr) {
                float acc[8];
#pragma unroll
                for (int j = 0; j < 8; ++j) acc[j] = 0.f;
#pragma unroll
                for (int ii = 0; ii < 4; ++ii) { float x[8]; unpack8(xr[rr + ii], x);
#pragma unroll
                    for (int j = 0; j < 4; ++j) { acc[j] += w0[ii][j] * x[j]; acc[4 + j] += w1[ii][j] * x[4 + j]; } }
                u32x4 o; o.x = pk2(silu(acc[0]), silu(acc[1])); o.y = pk2(silu(acc[2]), silu(acc[3])); o.z = pk2(silu(acc[4]), silu(acc[5])); o.w = pk2(silu(acc[6]), silu(acc[7]));
                *(u32x4*)(Qb + tz * (128 * 136) + (half * 64 + rb * 8 + rr) * 136 + cg8) = o;
            }
        }
    }
    LDS_BAR();
    {
        const int rowid = tid >> 1, part = tid & 1; bf16_t* pr = Qb + (rowid >> 7) * (128 * 136) + (rowid & 127) * 136 + part * 64;
        u32x4 w[8]; float ss = 0.f;
#pragma unroll
        for (int i = 0; i < 8; ++i) { w[i] = *(const u32x4*)(pr + 8 * i); float f[8]; unpack8(w[i], f);
#pragma unroll
            for (int j = 0; j < 8; ++j) ss += f[j] * f[j]; }
        ss += __shfl_xor(ss, 1);
        const float scl = rsqrtf(ss + EPS) * ((rowid < 128) ? 0.08838834764831845f : 1.0f);
#pragma unroll
        for (int i = 0; i < 8; ++i) { float f[8]; unpack8(w[i], f); u32x4 o; o.x = pk2(f[0] * scl, f[1] * scl); o.y = pk2(f[2] * scl, f[3] * scl); o.z = pk2(f[4] * scl, f[5] * scl); o.w = pk2(f[6] * scl, f[7] * scl);
            *(u32x4*)(pr + 8 * i) = o; }
    }
    if (tid < 128) {
        const float xs = av + a.in[11][l * 8 + h]; const float sp = (xs > 20.f) ? xs : log1pf(__expf(xs));
        float g = -__expf(a.in[10][l * 8 + h]) * sp;
#pragma unroll
        for (int o = 1; o < 64; o <<= 1) { const float t = __shfl_up(g, o); if (lane >= o) g += t; }
        gc[tid] = g; beta[tid] = sigm(bv); eg[tid] = __expf(g);
        if (lane == 63) ((float*)(a.ws + WS_GL))[ctask0 + wave] = __expf(g);
    }
    LDS_BAR();
    {
        const int c = wave & 1, isq = (wave >> 1) & 1, ip = wave >> 2; const bf16_t* Asrc = isq ? Qb : Kb;
        bf16x8 af[2][4], bfr[4][4];
#pragma unroll
        for (int i2 = 0; i2 < 2; ++i2)
#pragma unroll
            for (int ks = 0; ks < 4; ++ks) af[i2][ks] = *(const bf16x8*)(Asrc + (c * 64 + (2 * ip + i2) * 16 + l15) * 136 + ks * 32 + q * 8);
#pragma unroll
        for (int jt = 0; jt < 4; ++jt)
#pragma unroll
            for (int ks = 0; ks < 4; ++ks) bfr[jt][ks] = *(const bf16x8*)(Kb + (c * 64 + jt * 16 + l15) * 136 + ks * 32 + q * 8);
        SCHED_FENCE();
        f32x4 acc[2][4];
#pragma unroll
        for (int i2 = 0; i2 < 2; ++i2)
#pragma unroll
            for (int jt = 0; jt < 4; ++jt) acc[i2][jt] = (f32x4){0.f, 0.f, 0.f, 0.f};
#pragma unroll
        for (int ks = 0; ks < 4; ++ks)
#pragma unroll
            for (int i2 = 0; i2 < 2; ++i2)
#pragma unroll
                for (int jt = 0; jt < 4; ++jt) acc[i2][jt] = __builtin_amdgcn_mfma_f32_16x16x32_bf16(af[i2][ks], bfr[jt][ks], acc[i2][jt], 0, 0, 0);
        bf16_t* ATT = (bf16_t*)(a.ws + WS_REC + (size_t)(ctask0 + c) * REC_BYTES + REC_ATT); float* TTc = TTm + c * (64 * 68);
#pragma unroll
        for (int i2 = 0; i2 < 2; ++i2)
#pragma unroll
            for (int jt = 0; jt < 4; ++jt)
#pragma unroll
                for (int jj = 0; jj < 4; ++jj) { const int i = (2 * ip + i2) * 16 + q * 4 + jj, j = jt * 16 + l15; const float dg = gc[c * 64 + i] - gc[c * 64 + j];
                    if (isq) { const float v = (j <= i) ? acc[i2][jt][jj] * __expf(dg) : 0.f; ATT[i * 64 + j] = f2bf(v); }
                    else if (j < i) TTc[j * 68 + i] = beta[c * 64 + i] * acc[i2][jt][jj] * __expf(dg); }
    }
    LDS_BAR();
    {
        const int c = wave >> 2, col = tid & 255; int vz = 0; asm volatile("" : "+v"(vz));
        const float* betav = beta + c * 64 + vz; const float* egv = eg + c * 64 + vz; const LAS float* TTl = (const LAS float*)TTm + c * (64 * 68) + vz;
        unsigned char* rec = a.ws + WS_REC + (size_t)(ctask0 + c) * REC_BYTES;
        f32x2 r2[32];
        if (col < 128) {
#pragma unroll
            for (int k = 0; k < 32; ++k) r2[k] = (f32x2){bf1(Vb[(c * 64 + 2 * k) * 136 + col]) * betav[2 * k], bf1(Vb[(c * 64 + 2 * k + 1) * 136 + col]) * betav[2 * k + 1]};
        } else {
#pragma unroll
            for (int k = 0; k < 32; ++k) r2[k] = (f32x2){bf1(Kb[(c * 64 + 2 * k) * 136 + col - 128]) * betav[2 * k] * egv[2 * k], bf1(Kb[(c * 64 + 2 * k + 1) * 136 + col - 128]) * betav[2 * k + 1] * egv[2 * k + 1]};
        }
        f32x4 tb[2][16];
#pragma unroll
        for (int g = 0; g < 16; ++g) tb[0][g] = *(const volatile LAS f32x4*)(TTl + 4 * g);
#pragma unroll
        for (int j = 0; j < 63; ++j) {
            if (j + 1 < 63) {
#pragma unroll
                for (int g = ((j + 2) >> 2); g < 16; ++g) tb[(j + 1) & 1][g] = *(const volatile LAS f32x4*)(TTl + (j + 1) * 68 + 4 * g);
            }
            const float xj = (j & 1) ? r2[j >> 1].y : r2[j >> 1].x; const f32x2 xj2 = {xj, xj};
#pragma unroll
            for (int g = ((j + 1) >> 2); g < 16; ++g) { const f32x4 t4 = tb[j & 1][g]; const int i4 = 4 * g;
#pragma unroll
                for (int pp = 0; pp < 2; ++pp) { const int i0 = i4 + 2 * pp;
                    if (i0 > j) r2[i0 >> 1] -= (f32x2){t4[2 * pp], t4[2 * pp + 1]} * xj2;
                    else if (i0 + 1 > j) r2[i0 >> 1].y -= t4[2 * pp + 1] * xj; } } }
        if (col < 128) { bf16_t* UT = (bf16_t*)(rec + REC_UT) + col * 64;
#pragma unroll
            for (int i = 0; i < 8; ++i) { u32x4 w; w.x = pk2(r2[4 * i].x, r2[4 * i].y); w.y = pk2(r2[4 * i + 1].x, r2[4 * i + 1].y); w.z = pk2(r2[4 * i + 2].x, r2[4 * i + 2].y); w.w = pk2(r2[4 * i + 3].x, r2[4 * i + 3].y);
                *(u32x4*)(UT + 8 * i) = w; }
        } else { bf16_t* W = (bf16_t*)(rec + REC_W) + (col - 128);
#pragma unroll
            for (int k = 0; k < 32; ++k) { W[(2 * k) * 128] = f2bf(-r2[k].x); W[(2 * k + 1) * 128] = f2bf(-r2[k].y); } }
    }
#pragma unroll
    for (int i = 0; i < 4; ++i) { const int item = tid + 512 * i, tokr = item >> 4, cg8 = (item & 15) * 8, c = tokr >> 6, t = tokr & 63; const float e = eg[tokr];
        float f[8]; unpack8(*(const u32x4*)(Qb + tokr * 136 + cg8), f);
        u32x4 w; w.x = pk2(f[0] * e, f[1] * e); w.y = pk2(f[2] * e, f[3] * e); w.z = pk2(f[4] * e, f[5] * e); w.w = pk2(f[6] * e, f[7] * e);
        *(u32x4*)((bf16_t*)(a.ws + WS_REC + (size_t)(ctask0 + c) * REC_BYTES + REC_QD) + t * 128 + cg8) = w; }
#pragma unroll
    for (int i = 0; i < 4; ++i) { const int item = tid + 512 * i, d = item & 127, tg = (item >> 7) & 7, c = item >> 10; const float gl = gc[c * 64 + 63]; float v[8];
#pragma unroll
        for (int jj = 0; jj < 8; ++jj) v[jj] = bf1(Kb[(c * 64 + tg * 8 + jj) * 136 + d]) * __expf(gl - gc[c * 64 + tg * 8 + jj]);
        u32x4 w; w.x = pk2(v[0], v[1]); w.y = pk2(v[2], v[3]); w.z = pk2(v[4], v[5]); w.w = pk2(v[6], v[7]);
        *(u32x4*)((bf16_t*)(a.ws + WS_REC + (size_t)(ctask0 + c) * REC_BYTES + REC_KDT) + d * 64 + tg * 8) = w; }
    LDS_BAR();
}
__device__ __forceinline__ void task_scan(const Args& a, int l, unsigned char* lds, int task, int tid) {
    asm volatile("" : "+v"(tid));
    const int h = task & 7, b = task >> 3; const int wave = tid >> 6, lane = tid & 63, l15 = lane & 15, q = lane >> 4;
    const int rt = wave & 3, cb = (wave >> 2) * 4;
    const bf16_t* P = (const bf16_t*)(a.ws + WS_PROJ); bf16_t* YB = (bf16_t*)(a.ws + WS_YB); const float* GL = (const float*)(a.ws + WS_GL);
    bf16_t* ST0 = (bf16_t*)lds; bf16_t* ST1 = (bf16_t*)(lds + 34816); bf16_t* VT = (bf16_t*)(lds + 69632); float* RED = (float*)(lds + 88064);
    bf16_t* OT0 = (bf16_t*)(lds + 88576); bf16_t* OT1 = (bf16_t*)(lds + 88576 + 17408);
    for (int i = tid; i < 34816 / 16; i += NTHR) ((u32x4*)ST0)[i] = (u32x4){0u, 0u, 0u, 0u};
    f32x4 accS[8];
#pragma unroll
    for (int c = 0; c < 8; ++c) accS[c] = (f32x4){0.f, 0.f, 0.f, 0.f};
    const int ocg8 = (tid & 15) * 8, otok = tid >> 4;
    const float* gdp = a.in[12] + l * 128 + ocg8;
    const unsigned char* rec0 = a.ws + WS_REC + (size_t)(task * 32) * REC_BYTES;
    bf16x8 aw[4], aq[4], aat[2], ak[2]; f32x4 accP[4]; float gl;
#define SCAN_LD_A(rec) do { _Pragma("unroll") for (int ks = 0; ks < 4; ++ks) aw[ks] = *(const bf16x8*)((const bf16_t*)((rec) + REC_W) + (rt * 16 + l15) * 128 + ks * 32 + q * 8); \
        _Pragma("unroll") for (int t = 0; t < 4; ++t) { const u32x2 uw = *(const u32x2*)((const bf16_t*)((rec) + REC_UT) + ((cb + t) * 16 + l15) * 64 + rt * 16 + q * 4); accP[t] = (f32x4){bflo(uw.x), bfhi(uw.x), bflo(uw.y), bfhi(uw.y)}; } } while (0)
#define SCAN_LD_B(rec) do { _Pragma("unroll") for (int ks = 0; ks < 4; ++ks) aq[ks] = *(const bf16x8*)((const bf16_t*)((rec) + REC_QD) + (rt * 16 + l15) * 128 + ks * 32 + q * 8); \
        _Pragma("unroll") for (int ks = 0; ks < 2; ++ks) aat[ks] = *(const bf16x8*)((const bf16_t*)((rec) + REC_ATT) + (rt * 16 + l15) * 64 + ks * 32 + q * 8); } while (0)
#define SCAN_LD_C(rec, ct) do { _Pragma("unroll") for (int ks = 0; ks < 2; ++ks) ak[ks] = *(const bf16x8*)((const bf16_t*)((rec) + REC_KDT) + (wave * 16 + l15) * 64 + ks * 32 + q * 8); gl = GL[ct]; } while (0)
    SCAN_LD_A(rec0); SCAN_LD_B(rec0); SCAN_LD_C(rec0, task * 32);
    __syncthreads();
#pragma unroll 1
    for (int n = 0; n < 32; ++n) {
        const int np = (n + 1 < 32) ? n + 1 : 31; const unsigned char* recn = rec0 + (size_t)np * REC_BYTES;
        const bf16_t* STc = (n & 1) ? ST1 : ST0; bf16_t* STn = (n & 1) ? ST0 : ST1;
        u32x4 zbv[2];
        if (n > 0) {
#pragma unroll
            for (int i = 0; i < 2; ++i) zbv[i] = *(const u32x4*)(P + ((size_t)b * SEQ + (n - 1) * 64 + otok + 32 * i) * NPROJ + C_ZB + h * 128 + ocg8);
        }
        {
        bf16x8 sb[4][4];
#pragma unroll
        for (int t = 0; t < 4; ++t)
#pragma unroll
            for (int ks = 0; ks < 4; ++ks) sb[t][ks] = *(const bf16x8*)(STc + ((cb + t) * 16 + l15) * 136 + ks * 32 + q * 8);
        SCHED_FENCE();
#pragma unroll
        for (int ks = 0; ks < 4; ++ks)
#pragma unroll
            for (int t = 0; t < 4; ++t) accP[t] = __builtin_amdgcn_mfma_f32_16x16x32_bf16(aw[ks], sb[t][ks], accP[t], 0, 0, 0);
        SCHED_FENCE();
        }
#pragma unroll
        for (int t = 0; t < 4; ++t) { u32x2 w; w.x = pk2(accP[t][0], accP[t][1]); w.y = pk2(accP[t][2], accP[t][3]);
            *(u32x2*)(VT + ((cb + t) * 16 + l15) * 72 + rt * 16 + q * 4) = w; }
        SCAN_LD_A(recn);
        LDS_BAR();
        if (n > 0) {
            const bf16_t* OT = ((n - 1) & 1) ? OT1 : OT0; const f32x4 g0 = *(const f32x4*)gdp, g1 = *(const f32x4*)(gdp + 4); const float gd[8] = {g0[0], g0[1], g0[2], g0[3], g1[0], g1[1], g1[2], g1[3]};
#pragma unroll
            for (int i = 0; i < 2; ++i) { const int tok = otok + 32 * i; float o[8], z[8]; unpack8(*(const u32x4*)(OT + tok * 136 + ocg8), o); unpack8(zbv[i], z);
                u32x4 w; w.x = pk2(o[0] * gd[0] * silu(z[0]), o[1] * gd[1] * silu(z[1])); w.y = pk2(o[2] * gd[2] * silu(z[2]), o[3] * gd[3] * silu(z[3]));
                w.z = pk2(o[4] * gd[4] * silu(z[4]), o[5] * gd[5] * silu(z[5])); w.w = pk2(o[6] * gd[6] * silu(z[6]), o[7] * gd[7] * silu(z[7]));
                *(u32x4*)(YB + ((size_t)b * SEQ + (n - 1) * 64 + tok) * D + h * 128 + ocg8) = w; }
        }
        f32x4 accO[4];
#pragma unroll
        for (int t = 0; t < 4; ++t) accO[t] = (f32x4){0.f, 0.f, 0.f, 0.f};
        {
            bf16x8 sb2[4][4];
#pragma unroll
            for (int t = 0; t < 4; ++t)
#pragma unroll
                for (int ks = 0; ks < 4; ++ks) sb2[t][ks] = *(const bf16x8*)(STc + ((cb + t) * 16 + l15) * 136 + ks * 32 + q * 8);
            SCHED_FENCE();
#pragma unroll
            for (int ks = 0; ks < 4; ++ks)
#pragma unroll
                for (int t = 0; t < 4; ++t) accO[t] = __builtin_amdgcn_mfma_f32_16x16x32_bf16(sb2[t][ks], aq[ks], accO[t], 0, 0, 0);
            SCHED_FENCE();
        }
        {
            bf16x8 vb[4][2];
#pragma unroll
            for (int t = 0; t < 4; ++t)
#pragma unroll
                for (int ks = 0; ks < 2; ++ks) vb[t][ks] = *(const bf16x8*)(VT + ((cb + t) * 16 + l15) * 72 + ks * 32 + q * 8);
            SCHED_FENCE();
#pragma unroll
            for (int ks = 0; ks < 2; ++ks)
#pragma unroll
                for (int t = 0; t < 4; ++t) accO[t] = __builtin_amdgcn_mfma_f32_16x16x32_bf16(vb[t][ks], aat[ks], accO[t], 0, 0, 0);
            SCHED_FENCE();
        }
        SCAN_LD_B(recn);
        {
            float sq = 0.f;
#pragma unroll
            for (int t = 0; t < 4; ++t) sq += (accO[t][0] * accO[t][0] + accO[t][1] * accO[t][1]) + (accO[t][2] * accO[t][2] + accO[t][3] * accO[t][3]);
            sq += __shfl_xor(sq, 16); sq += __shfl_xor(sq, 32);
            if (q == 0) RED[(wave >> 2) * 64 + rt * 16 + l15] = sq;
        }
#pragma unroll
        for (int c = 0; c < 8; ++c) accS[c] = accS[c] * gl;
#pragma unroll
        for (int hf = 0; hf < 2; ++hf) {
            bf16x8 vb[4][2];
#pragma unroll
            for (int t = 0; t < 4; ++t)
#pragma unroll
                for (int ks = 0; ks < 2; ++ks) vb[t][ks] = *(const bf16x8*)(VT + ((hf * 4 + t) * 16 + l15) * 72 + ks * 32 + q * 8);
            SCHED_FENCE();
#pragma unroll
            for (int ks = 0; ks < 2; ++ks)
#pragma unroll
                for (int t = 0; t < 4; ++t) accS[hf * 4 + t] = __builtin_amdgcn_mfma_f32_16x16x32_bf16(ak[ks], vb[t][ks], accS[hf * 4 + t], 0, 0, 0);
            SCHED_FENCE();
        }
#pragma unroll
        for (int c = 0; c < 8; ++c) { u32x2 w; w.x = pk2(accS[c][0], accS[c][1]); w.y = pk2(accS[c][2], accS[c][3]);
            *(u32x2*)(STn + (c * 16 + l15) * 136 + wave * 16 + q * 4) = w; }
        SCAN_LD_C(recn, task * 32 + np);
        LDS_BAR();
        {
            bf16_t* OT = (n & 1) ? OT1 : OT0;
            const float rs = rsqrtf((RED[rt * 16 + l15] + RED[64 + rt * 16 + l15]) * (1.f / 128.f) + EPS);
#pragma unroll
            for (int t = 0; t < 4; ++t) { u32x2 w; w.x = pk2(accO[t][0] * rs, accO[t][1] * rs); w.y = pk2(accO[t][2] * rs, accO[t][3] * rs);
                *(u32x2*)(OT + (rt * 16 + l15) * 136 + (cb + t) * 16 + q * 4) = w; }
        }
    }
    __syncthreads();
    {
        const f32x4 g0 = *(const f32x4*)gdp, g1 = *(const f32x4*)(gdp + 4); const float gd[8] = {g0[0], g0[1], g0[2], g0[3], g1[0], g1[1], g1[2], g1[3]};
#pragma unroll
        for (int i = 0; i < 2; ++i) { const int tok = otok + 32 * i; float o[8], z[8]; unpack8(*(const u32x4*)(OT1 + tok * 136 + ocg8), o);
            unpack8(*(const u32x4*)(P + ((size_t)b * SEQ + 31 * 64 + tok) * NPROJ + C_ZB + h * 128 + ocg8), z);
            u32x4 w; w.x = pk2(o[0] * gd[0] * silu(z[0]), o[1] * gd[1] * silu(z[1])); w.y = pk2(o[2] * gd[2] * silu(z[2]), o[3] * gd[3] * silu(z[3]));
            w.z = pk2(o[4] * gd[4] * silu(z[4]), o[5] * gd[5] * silu(z[5])); w.w = pk2(o[6] * gd[6] * silu(z[6]), o[7] * gd[7] * silu(z[7]));
            *(u32x4*)(YB + ((size_t)b * SEQ + 31 * 64 + tok) * D + h * 128 + ocg8) = w; }
    }
#undef SCAN_LD_A
#undef SCAN_LD_B
#undef SCAN_LD_C
    float* So = a.out + O_GP + (((size_t)l * NB + b) * 8 + h) * 16384;
#pragma unroll
    for (int c = 0; c < 8; ++c)
#pragma unroll
        for (int jj = 0; jj < 4; ++jj) So[(wave * 16 + q * 4 + jj) * 128 + c * 16 + l15] = accS[c][jj];
    __syncthreads();
}
__device__ __forceinline__ void task_conv_state_prompt(const Args& a, int l, int tid) {
    asm volatile("" : "+v"(tid));
    const bf16_t* P = (const bf16_t*)(a.ws + WS_PROJ);
    for (int i = tid; i < NB * 3 * CONVD; i += NTHR) { const int c = i % CONVD, r = (i / CONVD) % 3, b = i / (3 * CONVD);
        a.out[O_CP + (size_t)l * NB * 3 * CONVD + i] = bf1(P[(size_t)(b * SEQ + SEQ - 3 + r) * NPROJ + C_QKV + c]); }
}
template <int NT>
__device__ __forceinline__ void sg_core(const bf16_t* Arow, const bf16_t* Brow, f32x4 (&acc)[NT]) {
    constexpr int KB = (NT == 1) ? 8 : 4;
#pragma unroll 1
    for (int k0 = 0; k0 < 32; k0 += KB) {
        bf16x8 af[KB], bfr[KB][NT];
#pragma unroll
        for (int u = 0; u < KB; ++u) { af[u] = *(const bf16x8*)(Arow + (k0 + u) * 32);
#pragma unroll
            for (int t = 0; t < NT; ++t) bfr[u][t] = *(const bf16x8*)(Brow + (size_t)t * 16 * D + (k0 + u) * 32); }
        SCHED_FENCE();
#pragma unroll
        for (int u = 0; u < KB; ++u)
#pragma unroll
            for (int t = 0; t < NT; ++t) acc[t] = __builtin_amdgcn_mfma_f32_16x16x32_bf16(bfr[u][t], af[u], acc[t], 0, 0, 0);
        SCHED_FENCE();
    }
}
__device__ __forceinline__ void sg_core2(const bf16_t* A0, const bf16_t* B0, const bf16_t* A1, const bf16_t* B1, f32x4& acc0, f32x4& acc1) {
#pragma unroll 1
    for (int k0 = 0; k0 < 32; k0 += 8) {
        bf16x8 a0[8], b0[8], a1[8], b1[8];
#pragma unroll
        for (int u = 0; u < 8; ++u) { a0[u] = *(const bf16x8*)(A0 + (k0 + u) * 32); b0[u] = *(const bf16x8*)(B0 + (k0 + u) * 32); a1[u] = *(const bf16x8*)(A1 + (k0 + u) * 32); b1[u] = *(const bf16x8*)(B1 + (k0 + u) * 32); }
        SCHED_FENCE();
#pragma unroll
        for (int u = 0; u < 8; ++u) { acc0 = __builtin_amdgcn_mfma_f32_16x16x32_bf16(b0[u], a0[u], acc0, 0, 0, 0); acc1 = __builtin_amdgcn_mfma_f32_16x16x32_bf16(b1[u], a1[u], acc1, 0, 0, 0); }
        SCHED_FENCE();
    }
}
__device__ __forceinline__ void small_p1(const Args& a, int l, int it, int tid) {
    asm volatile("" : "+v"(tid));
    const int wave = tid >> 6, lane = tid & 63, l15 = lane & 15, q = lane >> 4;
    const bf16_t* H = (const bf16_t*)(a.ws + WS_H); const bf16_t* W = (const bf16_t*)(a.ws + WS_W1T) + (size_t)l * NW1 * D; bf16_t* P = (bf16_t*)(a.ws + WS_PROJ); float* AB = (float*)(a.ws + WS_AB);
    if (it < 64) {
#pragma unroll 1
        for (int rb2 = 0; rb2 < 2; ++rb2) {
            const int row = it * 256 + rb2 * 128 + wave * 16 + l15; f32x4 acc[1] = {(f32x4){0.f, 0.f, 0.f, 0.f}};
            sg_core<1>(H + (size_t)row * D + q * 8, W + (size_t)(NPROJ + l15) * D + q * 8, acc);
            *(f32x4*)(AB + (size_t)row * 16 + q * 4) = acc[0];
        }
    } else {
        const int ct = it - 64, n0 = ct * 64, row = TP + wave * 16 + l15; f32x4 acc[4];
#pragma unroll
        for (int t = 0; t < 4; ++t) acc[t] = (f32x4){0.f, 0.f, 0.f, 0.f};
        sg_core<4>(H + (size_t)row * D + q * 8, W + (size_t)(n0 + l15) * D + q * 8, acc);
        if (ct < 144) {
#pragma unroll
            for (int t = 0; t < 4; ++t) { u32x2 w; w.x = pk2(acc[t][0], acc[t][1]); w.y = pk2(acc[t][2], acc[t][3]); *(u32x2*)(P + (size_t)row * NPROJ + n0 + t * 16 + q * 4) = w; }
        } else *(f32x4*)(AB + (size_t)row * 16 + q * 4) = acc[0];
    }
}
__device__ __forceinline__ void small_p4(const Args& a, int l, int it, int tid) {
    asm volatile("" : "+v"(tid));
    const int wave = tid >> 6, lane = tid & 63, l15 = lane & 15, q = lane >> 4; const int n0 = it * 16, row = TP + wave * 16 + l15;
    const bf16_t* P = (const bf16_t*)(a.ws + WS_PROJ);
    f32x4 accA[1] = {(f32x4){0.f, 0.f, 0.f, 0.f}}, accB[1] = {(f32x4){0.f, 0.f, 0.f, 0.f}};
    sg_core2((const bf16_t*)(a.ws + WS_YA) + (size_t)row * D + q * 8, (const bf16_t*)(a.ws + WS_WPA) + (size_t)l * D * D + (size_t)(n0 + l15) * D + q * 8,
             (const bf16_t*)(a.ws + WS_YB) + (size_t)row * D + q * 8, (const bf16_t*)(a.ws + WS_WPB) + (size_t)l * D * D + (size_t)(n0 + l15) * D + q * 8, accA[0], accB[0]);
    const u32x2 ga = *(const u32x2*)(P + (size_t)row * NPROJ + C_GA + n0 + q * 4), gb = *(const u32x2*)(P + (size_t)row * NPROJ + C_GB + n0 + q * 4);
    const float m0 = sigm(bflo(ga.x)) * accA[0][0] + sigm(bflo(gb.x)) * accB[0][0], m1 = sigm(bfhi(ga.x)) * accA[0][1] + sigm(bfhi(gb.x)) * accB[0][1];
    const float m2 = sigm(bflo(ga.y)) * accA[0][2] + sigm(bflo(gb.y)) * accB[0][2], m3 = sigm(bfhi(ga.y)) * accA[0][3] + sigm(bfhi(gb.y)) * accB[0][3];
    u32x2 w; w.x = pk2(m0, m1); w.y = pk2(m2, m3);
    *(u32x2*)((bf16_t*)(a.ws + WS_MERGED) + (size_t)row * D + n0 + q * 4) = w;
}
__device__ __forceinline__ void small_p5(const Args& a, int l, int it, int tid) {
    asm volatile("" : "+v"(tid));
    const int wave = tid >> 6, lane = tid & 63, l15 = lane & 15, q = lane >> 4; const int n0 = it * 16, row = TP + wave * 16 + l15;
    f32x4 acc[1] = {(f32x4){0.f, 0.f, 0.f, 0.f}};
    sg_core<1>((const bf16_t*)(a.ws + WS_MERGED) + (size_t)row * D + q * 8, (const bf16_t*)(a.ws + WS_WOUT) + (size_t)l * D * D + (size_t)(n0 + l15) * D + q * 8, acc);
    { u32x2 w; w.x = pk2(acc[0][0], acc[0][1]); w.y = pk2(acc[0][2], acc[0][3]); *(u32x2*)((bf16_t*)(a.ws + WS_TMP) + (size_t)row * D + n0 + q * 4) = w; }
}
#define XB_TMO      128
#define XB_XCNT(j)  (256  + 64 * (j))
#define XB_XSUB(j)  (1280 + 64 * (j))
#define XB_XGEN(j)  (2304 + 64 * (j))
#define XB_TOP      3328
#define XB_TOPGEN   3392
#define XCD_BAR_WORDS 3456
#define XB_SPIN_CAP (1u << 18)

__device__ __forceinline__ unsigned xb_ld(unsigned* p)              { return __hip_atomic_load(p, __ATOMIC_RELAXED, __HIP_MEMORY_SCOPE_AGENT); }
__device__ __forceinline__ unsigned xb_add(unsigned* p, unsigned v) { return __hip_atomic_fetch_add(p, v, __ATOMIC_RELAXED, __HIP_MEMORY_SCOPE_AGENT); }
__device__ __forceinline__ unsigned xb_xcc_id() { return (unsigned)__builtin_amdgcn_s_getreg((3 << 11) | 20) & 0xFu; }
#define XB_SPIN(cond, bar) do { unsigned _sp = 0; while (cond) { __builtin_amdgcn_s_sleep(1); \
    if ((++_sp & 255u) == 0u) { if (xb_ld(&(bar)[XB_TMO])) break; if (_sp > XB_SPIN_CAP) { atomicAdd(&(bar)[XB_TMO], 1u); break; } } } } while (0)

struct XcdBarrier {
    unsigned* bar; unsigned x;
    volatile LAS unsigned* st;
};

__device__ __forceinline__ XcdBarrier xcd_barrier_post(unsigned* bar, volatile LAS unsigned* st) {
    XcdBarrier b; b.bar = bar; b.x = xb_xcc_id(); b.st = st;
    if (threadIdx.x == 0) (void)xb_add(&bar[XB_XCNT(b.x)], 1u);
    return b;
}
__device__ __forceinline__ void xcd_barrier_complete(unsigned* bar, unsigned x, unsigned& nloc, unsigned& nx) {
    const unsigned G = gridDim.x * gridDim.y * gridDim.z;
    unsigned sum, cnt, mine, sp = 0u;
    for (;;) {
        sum = 0u; cnt = 0u; mine = 0u;
#pragma unroll
        for (unsigned j = 0; j < 16; ++j) { const unsigned c = xb_ld(&bar[XB_XCNT(j)]); sum += c; cnt += (c > 0u) ? 1u : 0u; mine = (j == x) ? c : mine; }
        if (sum == G) break;
        __builtin_amdgcn_s_sleep(1);
        if ((++sp & 255u) == 0u) { if (xb_ld(&bar[XB_TMO])) break; if (sp > XB_SPIN_CAP) { atomicAdd(&bar[XB_TMO], 1u); break; } }
    }
    nloc = mine > 0u ? mine : 1u; nx = cnt > 0u ? cnt : 1u;
}

__device__ __forceinline__ void xcd_barrier(const XcdBarrier& b) {
    asm volatile("s_waitcnt vmcnt(0)" ::: "memory");
    __syncthreads();
    if (threadIdx.x == 0) {
        unsigned* bar = b.bar;
        __builtin_amdgcn_s_waitcnt(0);
        unsigned nloc = b.st[0], nx = b.st[1];
        if (nloc == 0u) { xcd_barrier_complete(bar, b.x, nloc, nx); b.st[0] = nloc; b.st[1] = nx; }
        const unsigned old = xb_add(&bar[XB_XSUB(b.x)], 1u);
        const unsigned gen = old / nloc;
        if (old + 1u == (gen + 1u) * nloc) {
            __builtin_amdgcn_fence(__ATOMIC_RELEASE, "agent");
            asm volatile("s_waitcnt vmcnt(0)" ::: "memory");
            const unsigned og = xb_add(&bar[XB_TOP], 1u);
            const unsigned tg = og / nx;
            if (og + 1u == (tg + 1u) * nx) xb_add(&bar[XB_TOPGEN], 1u);
            else XB_SPIN(xb_ld(&bar[XB_TOPGEN]) == tg, bar);
            __builtin_amdgcn_fence(__ATOMIC_ACQUIRE, "agent");
            xb_add(&bar[XB_XGEN(b.x)], 1u);
            asm volatile("s_waitcnt vmcnt(0)" ::: "memory");
        } else {
            XB_SPIN(xb_ld(&bar[XB_XGEN(b.x)]) == gen, bar);
            __builtin_amdgcn_fence(__ATOMIC_ACQUIRE, "agent");
            asm volatile("s_waitcnt vmcnt(0)" ::: "memory");
        }
    }
    __syncthreads();
}
__global__ void __launch_bounds__(NTHR) mega_fwd(Args a) {
    extern __shared__ __attribute__((aligned(16))) unsigned char lds[];
    cg::grid_group grid = cg::this_grid();
    const int tid = threadIdx.x, wg = blockIdx.x, G = gridDim.x;
    bf16_t* H = (bf16_t*)(a.ws + WS_H); bf16_t* PROJ = (bf16_t*)(a.ws + WS_PROJ); float* AB = (float*)(a.ws + WS_AB);
    bf16_t* YA = (bf16_t*)(a.ws + WS_YA); bf16_t* YB = (bf16_t*)(a.ws + WS_YB); float* TMP = (float*)(a.ws + WS_TMP); bf16_t* MG = (bf16_t*)(a.ws + WS_MERGED);
    #ifndef NO_P0
    volatile LAS unsigned* bst = (volatile LAS unsigned*)((LAS unsigned char*)lds + LDS_BYTES - 16);
    if (tid < 4) bst[tid] = 0u;
    __syncthreads();
    if (wg == 0) { for (int i = tid; i < XCD_BAR_WORDS; i += NTHR) ((unsigned*)a.ws)[i] = 0u; }
    phase_prologue(a, lds, wg, G, tid);
#endif
    grid.sync();
    const XcdBarrier bar = xcd_barrier_post((unsigned*)a.ws, bst);
#pragma unroll 1
    for (int l = 0; l < DEPTH; ++l) {
#ifndef NO_P1
        {
            pg8::Gemm g{H, (const bf16_t*)(a.ws + WS_W1T) + (size_t)l * NW1 * D, TP, NPROJ, D}; pg8::StaticOrder S; S.init(TP, NPROJ, G, wg);
            Epi1 E{PROJ, AB}; pg8::gemm_phase<Epi1, pg8::StaticOrder>((LAS unsigned char*)lds, g, S, E, nullptr);
            for (int it = wg; it < 64 + 145; it += G) small_p1(a, l, it, tid);
        }
#endif
        xcd_barrier(bar);
#ifndef NO_P2
        phase_vrstd(a, wg, G, tid);
        for (int t = wg; t < NB * 8 * 16; t += G) task_prep2(a, l, lds, NB * 8 * 16 - 1 - t, tid);
#endif
        xcd_barrier(bar);
        {
#ifndef NO_SCAN
            for (int t = wg; t < 64; t += G) task_scan(a, l, lds, t, tid);
#endif
            const int o = (G > 64) ? wg - 64 : wg, stride = (G > 64) ? G - 64 : G;
#ifndef NO_P3O
            if (o >= 0) {
                constexpr int N_DS = DB * 8, N_GP = 1024, N_GS = DB / 8, N_ALL = N_DS + N_GP + N_GS + 1;
                for (int it = o; it < N_ALL; it += stride) {
                    if (it < N_DS) task_delta_sample(a, l, lds, it, tid);
                    else if (it < N_DS + N_GP) task_gmlp_prompt(a, l, lds, N_GP - 1 - (it - N_DS), tid);
                    else if (it < N_DS + N_GP + N_GS) task_gmlp_sample(a, l, it - N_DS - N_GP, tid);
                    else task_conv_state_prompt(a, l, tid);
                }
                if (l + 1 < DEPTH) { __syncthreads(); phase_weights(a, lds, l + 1, o, stride, tid); }
            }
#endif
        }
        xcd_barrier(bar);
#ifndef NO_P4
        {
            PairOrder S; S.init(TP, D, G, wg);
            { pg8::Gemm g{YA, (const bf16_t*)(a.ws + WS_WPA) + (size_t)l * D * D, TP, D, D}; Epi2ab E{PROJ, MG}; pg8::gemm_phase<Epi2ab, PairOrder>((LAS unsigned char*)lds, g, S, E, nullptr); }
            for (int it = wg; it < 64; it += G) small_p4(a, l, it, tid);
        }
#endif
        xcd_barrier(bar);
#ifndef NO_P5
        {
            pg8::StaticOrder S; S.init(TP, D, G, wg);
            pg8::Gemm g{MG, (const bf16_t*)(a.ws + WS_WOUT) + (size_t)l * D * D, TP, D, D}; Epi3 E{(bf16_t*)(a.ws + WS_TMP)}; pg8::gemm_phase<Epi3, pg8::StaticOrder>((LAS unsigned char*)lds, g, S, E, nullptr);
            for (int it = wg; it < 64; it += G) small_p5(a, l, it, tid);
        }
#endif
        xcd_barrier(bar);
#ifndef NO_P6
        phase_residual(a, l, wg, G, tid);
#endif
        xcd_barrier(bar);
    }
}
extern "C" void kernel_launch(void* const* d_in, const int* in_sizes, int n_in, void* d_out, int out_size, void* d_ws, size_t ws_size, hipStream_t stream) {
    static int grid = 0;
    if (grid == 0) {
        int dev = 0, cus = 0, per_cu = 0;
        hipGetDevice(&dev); hipDeviceGetAttribute(&cus, hipDeviceAttributeMultiprocessorCount, dev);
        if (hipFuncSetAttribute((const void*)mega_fwd, hipFuncAttributeMaxDynamicSharedMemorySize, LDS_BYTES) != hipSuccess) fprintf(stderr, "hipFuncSetAttribute failed\n");
        if (hipOccupancyMaxActiveBlocksPerMultiprocessor(&per_cu, (const void*)mega_fwd, NTHR, LDS_BYTES) != hipSuccess || per_cu < 1) { fprintf(stderr, "occupancy query: %d\n", per_cu); per_cu = 1; }
        (void)hipGetLastError();
        grid = cus;
        if (ws_size < WS_END) { fprintf(stderr, "workspace too small: %zu < %zu\n", ws_size, (size_t)WS_END); grid = -1; }
    }
    if (grid < 0) return;
    Args a{};
    for (int i = 0; i < 17; ++i) a.in[i] = (const float*)d_in[i];
    a.out = (float*)d_out; a.ws = (unsigned char*)d_ws;
    void* args[] = {&a};
    hipError_t e = hipLaunchCooperativeKernel((const void*)mega_fwd, dim3(grid), dim3(NTHR), args, LDS_BYTES, stream);
    if (e != hipSuccess) fprintf(stderr, "cooperative launch failed: %s (grid %d)\n", hipGetErrorString(e), grid);
}
```

```cpp
#include <hip/hip_runtime.h>
#include <hip/hip_cooperative_groups.h>
#include <cstdio>
namespace cg = cooperative_groups;
namespace pg8 {
#define PG8_LAS __attribute__((address_space(3)))
typedef unsigned short bf16_t;
typedef short bf16x8 __attribute__((ext_vector_type(8)));
typedef float f32x4 __attribute__((ext_vector_type(4)));
typedef unsigned u32x4 __attribute__((ext_vector_type(4)));
constexpr int BM = 256, BK = 64, HALF = 128, HTB = HALF * BK * 2  , STAGE_BYTES = 8 * HTB, NXCD = 8, WGM = 8;

__host__ __device__ __forceinline__ int lds_byte(int r, int c) { const int st = (r >> 4) * 2 + (c >> 5), rr = r & 15, cc = c & 31, ob = rr * 64 + cc * 2; return st * 1024 + (ob ^ (((ob >> 9) & 1) << 5)); }
__host__ __device__ __forceinline__ void stage_rc(int b, int& R, int& C) { const int st = b / 1024, sb = b % 1024, swz = sb ^ (((sb >> 9) & 1) << 5); R = (st >> 1) * 16 + swz / 64; C = (st & 1) * 32 + (swz % 64) / 2; }
__host__ __device__ __forceinline__ int perm32(int rho) { const int n = rho >> 4, i = rho & 15; return 8 * (i >> 2) + 4 * n + (i & 3); }

struct Unit { int pm, pn; };
struct Gemm { const bf16_t* A; const bf16_t* Bt; int M, N, K; };

struct StaticOrder {
    int nM, nN, nwg, G, c;
    __host__ __device__ void init(int M, int N, int G_, int c_) { nM = M / BM; nN = N / BM; nwg = nM * nN; G = G_; c = c_; }
    __host__ __device__ bool next(int i, Unit& u) const {
        const long L = (long)i * G + c; if (L >= nwg) return false;
        int wgid = (int)L; { const int q = nwg / NXCD, r = nwg % NXCD, xcd = wgid % NXCD, off = wgid / NXCD; wgid = (xcd < r ? xcd * (q + 1) : r * (q + 1) + (xcd - r) * q) + off; }
        const int nig = WGM * nN, gid = wgid / nig, fm = gid * WGM, gsz = (nM - fm) < WGM ? (nM - fm) : WGM;
        u.pm = fm + ((wgid % nig) % gsz); u.pn = (wgid % nig) / gsz; return true;
    }
    __device__ __forceinline__ void a_ready(const Unit&) const {}
    __device__ __forceinline__ void done(const Unit&) const {}
};
typedef float f32x2c __attribute__((ext_vector_type(2))); typedef __bf16 bf16x2c __attribute__((ext_vector_type(2)));
__device__ __forceinline__ unsigned cvt_pk_bf16(float lo, float hi) { const f32x2c v = {lo, hi}; const bf16x2c r = __builtin_convertvector(v, bf16x2c); return __builtin_bit_cast(unsigned, r); }
template <class Epi, class Sched, bool STAMP = false>
__device__ __forceinline__ void gemm_phase(PG8_LAS unsigned char* lds, const Gemm g, const Sched& S, const Epi& E, unsigned long long* stamps) {
    int tid_opq = threadIdx.x; asm volatile("" : "+v"(tid_opq));
    const int tid = tid_opq, wid = __builtin_amdgcn_readfirstlane(tid >> 6), lane = tid & 63, wr = wid >> 2, wc = wid & 3, fr = lane & 15, fq = lane >> 4;
    const int K = g.K, nt = K / BK;
    int ts_lo = 0, ts_hi = 0, nts = 0; const unsigned long long rt_entry = STAMP ? (unsigned long long)wall_clock64() : 0ull;
#define PG8_STAMP() do { if (STAMP && wid == 0 && nts < 64) { const unsigned long long _c = (unsigned long long)clock64(); \
        ts_lo = (lane == nts) ? (int)(unsigned)_c : ts_lo; ts_hi = (lane == nts) ? (int)(unsigned)(_c >> 32) : ts_hi; ++nts; } } while (0)
    PG8_STAMP();
    unsigned voffA[2], voffB[2];
#pragma unroll
    for (int i = 0; i < 2; ++i) { int R, C; stage_rc(tid * 16 + i * 8192, R, C); const int Rb = Epi::PERM ? ((R & ~31) + perm32(R & 31)) : R;
        voffA[i] = (unsigned)(R * K + C) * 2u; voffB[i] = (unsigned)(Rb * K + C) * 2u; }
    const size_t kstep = (size_t)(BK * 2);
    const size_t hstep = (size_t)HALF * K * 2;
    const size_t tstep = 2 * hstep;
    const unsigned ldsw = (unsigned)wid * 1024u;
    const int aoff = lds_byte(wr * 64 + fr, fq * 8), boff = lds_byte(wc * 32 + fr, fq * 8);
#define PG8_SA(b, h) (((b) * 2 + (h)) * HTB)
#define PG8_SB(b, h) ((4 + (b) * 2 + (h)) * HTB)
#define PG8_STAGE(bufoff, gbase, voff) do { _Pragma("unroll") for (int _i = 0; _i < 2; ++_i) \
        __builtin_amdgcn_global_load_lds((const unsigned*)((const char*)(gbase) + (voff)[_i]), (PG8_LAS unsigned*)(lds + (bufoff) + ldsw + _i * 8192), 16, 0, 0); } while (0)
#define PG8_LDA(dst, b, h) do { _Pragma("unroll") for (int m = 0; m < 4; ++m) _Pragma("unroll") for (int k = 0; k < 2; ++k) dst[m][k] = *(const PG8_LAS bf16x8*)(lds + PG8_SA(b, h) + aoff + m * 2048 + k * 1024); } while (0)
#define PG8_LDB(dst, b, h) do { _Pragma("unroll") for (int n = 0; n < 2; ++n) _Pragma("unroll") for (int k = 0; k < 2; ++k) dst[n][k] = *(const PG8_LAS bf16x8*)(lds + PG8_SB(b, h) + boff + n * 2048 + k * 1024); } while (0)
#define PG8_MMA(ai, bj, At, Bt) do { __builtin_amdgcn_s_setprio(1); _Pragma("unroll") for (int m = 0; m < 4; ++m) _Pragma("unroll") for (int n = 0; n < 2; ++n) _Pragma("unroll") for (int k = 0; k < 2; ++k) \
        acc[ai][bj][m][n] = __builtin_amdgcn_mfma_f32_16x16x32_bf16(Bt[n][k], At[m][k], acc[ai][bj][m][n], 0, 0, 0); __builtin_amdgcn_s_setprio(0); } while (0)
#define PG8_WAIT_V(n) asm volatile("s_waitcnt vmcnt(" #n ")" ::: "memory")
#define PG8_WAIT_L(n) asm volatile("s_waitcnt lgkmcnt(" #n ")" ::: "memory")
#define PG8_BAR __builtin_amdgcn_s_barrier()
#define PG8_SCHED __builtin_amdgcn_sched_barrier(0)
    Unit cur, nxt; int ui = 0;
    if (!S.next(0, cur)) return;
    f32x4 acc[2][2][4][2];
#pragma unroll
    for (int a = 0; a < 2; ++a)
#pragma unroll
        for (int b = 0; b < 2; ++b)
#pragma unroll
            for (int m = 0; m < 4; ++m)
#pragma unroll
                for (int n = 0; n < 2; ++n) acc[a][b][m][n] = (f32x4){0.f, 0.f, 0.f, 0.f};
    bf16x8 At[4][2], B0[2][2], B1[2][2];
    const char* cA = (const char*)g.A + (size_t)cur.pm * tstep; const char* cB = (const char*)g.Bt + (size_t)cur.pn * tstep;
    S.a_ready(cur);
    PG8_STAGE(PG8_SB(0, 0), cB, voffB); PG8_STAGE(PG8_SA(0, 0), cA, voffA); PG8_STAGE(PG8_SB(0, 1), cB + hstep, voffB); PG8_STAGE(PG8_SA(0, 1), cA + hstep, voffA);
    if (wr == 1) PG8_BAR;
    PG8_WAIT_V(4); PG8_BAR;
    PG8_STAGE(PG8_SB(1, 0), cB + kstep, voffB); PG8_STAGE(PG8_SA(1, 0), cA + kstep, voffA); PG8_STAGE(PG8_SB(1, 1), cB + hstep + kstep, voffB);
    PG8_WAIT_V(6); PG8_BAR;
    PG8_STAMP();
    for (;;) {
        const bool has_next = S.next(ui + 1, nxt);
        const char* nA = has_next ? (const char*)g.A + (size_t)nxt.pm * tstep : cA; const char* nB = has_next ? (const char*)g.Bt + (size_t)nxt.pn * tstep : cB;
        for (int t = 0; t < nt; t += 2) {
            const bool last = (t == nt - 2);
            const char* a1 = cA + (size_t)(t + 1) * kstep;
            const char* a2 = last ? nA : cA + (size_t)(t + 2) * kstep; const char* b2 = last ? nB : cB + (size_t)(t + 2) * kstep;
            const char* a3 = a2 + kstep; const char* b3 = b2 + kstep;
            if (last && has_next) S.a_ready(nxt);
            PG8_LDB(B0, 0, 0); PG8_SCHED; PG8_LDA(At, 0, 0); PG8_STAGE(PG8_SA(1, 1), a1 + hstep, voffA);
            PG8_WAIT_L(8); PG8_BAR; PG8_WAIT_L(0); PG8_MMA(0, 0, At, B0); PG8_BAR; PG8_SCHED;
            PG8_LDB(B1, 0, 1); PG8_STAGE(PG8_SB(0, 0), b2, voffB);
            PG8_BAR; PG8_WAIT_L(0); PG8_MMA(0, 1, At, B1); PG8_BAR;
            PG8_LDA(At, 0, 1); PG8_STAGE(PG8_SA(0, 0), a2, voffA);
            PG8_BAR; PG8_WAIT_L(0); PG8_MMA(1, 0, At, B0); PG8_BAR; PG8_SCHED;
            PG8_STAGE(PG8_SB(0, 1), b2 + hstep, voffB);
            PG8_WAIT_V(6); PG8_BAR; PG8_MMA(1, 1, At, B1); PG8_BAR;
            PG8_LDB(B0, 1, 0); PG8_SCHED; PG8_LDA(At, 1, 0); PG8_STAGE(PG8_SA(0, 1), a2 + hstep, voffA);
            PG8_WAIT_L(8); PG8_BAR; PG8_WAIT_L(0); PG8_MMA(0, 0, At, B0); PG8_BAR; PG8_SCHED;
            PG8_LDB(B1, 1, 1); PG8_STAGE(PG8_SB(1, 0), b3, voffB);
            PG8_BAR; PG8_WAIT_L(0); PG8_MMA(0, 1, At, B1); PG8_BAR;
            PG8_LDA(At, 1, 1); PG8_STAGE(PG8_SA(1, 0), a3, voffA);
            PG8_BAR; PG8_WAIT_L(0); PG8_MMA(1, 0, At, B0); PG8_BAR; PG8_SCHED;
            PG8_STAGE(PG8_SB(1, 1), b3 + hstep, voffB);
            PG8_WAIT_V(6); PG8_BAR; PG8_MMA(1, 1, At, B1); PG8_BAR;
        }
        PG8_STAMP();
        if constexpr (!Epi::AFTER_DRAIN) { E(acc, cur, wr, wc, fr, fq); S.done(cur); }
        PG8_STAMP();
        if (!has_next) break;
        bool zero_acc = true;
        if constexpr (Epi::KEEP) zero_acc = !E.keep(cur);
        if (zero_acc) {
#pragma unroll
        for (int a = 0; a < 2; ++a)
#pragma unroll
            for (int b = 0; b < 2; ++b)
#pragma unroll
                for (int m = 0; m < 4; ++m)
#pragma unroll
                    for (int n = 0; n < 2; ++n) acc[a][b][m][n] = (f32x4){0.f, 0.f, 0.f, 0.f};
        }
        cur = nxt; cA = nA; cB = nB; ++ui;
    }
    PG8_WAIT_V(0);
    if (wr == 0) PG8_BAR;
    PG8_BAR;
    if constexpr (Epi::AFTER_DRAIN) { E.fused(acc, cur, wr, wc, fr, fq, lds, wid, lane); S.done(cur); }
    PG8_STAMP();
    if (STAMP && wid == 0) { stamps[lane] = lane < nts ? (((unsigned long long)(unsigned)ts_hi << 32) | (unsigned)ts_lo) : 0ull;
        if (lane == 62) stamps[62] = rt_entry; if (lane == 63) stamps[63] = (unsigned long long)wall_clock64(); }
#undef PG8_STAMP
#undef PG8_SA
#undef PG8_SB
#undef PG8_STAGE
#undef PG8_LDA
#undef PG8_LDB
#undef PG8_MMA
#undef PG8_WAIT_V
#undef PG8_WAIT_L
#undef PG8_BAR
#undef PG8_SCHED
}
}
using pg8::bf16_t; using pg8::bf16x8; using pg8::f32x4; using pg8::u32x4; using pg8::Unit;
typedef unsigned u32x2 __attribute__((ext_vector_type(2)));
#define LAS __attribute__((address_space(3)))

constexpr int D = 1024, NB = 8, SEQ = 2048, DEPTH = 4, DB = 128, TP = NB * SEQ, TT = TP + DB, MP = 16640;
constexpr int INDIM = 9232, NPROJ = 9216, NW1 = 9472, CONVD = 3072;
constexpr int C_U = 0, C_V = 1024, C_Z = 2048, C_QKV = 3072, C_ZB = 6144, C_GA = 7168, C_GB = 8192;
constexpr float EPS = 1e-6f;
constexpr int NTHR = 512;
constexpr int LDS_BYTES = 147456;
constexpr size_t MiB = 1u << 20;
constexpr size_t WS_RSTDV = 512 * 1024;
constexpr size_t WS_W1T = 1 * MiB, WS_WPA = 75 * MiB, WS_WPB = 83 * MiB, WS_WOUT = 91 * MiB, WS_H = 99 * MiB, WS_PROJ = 132 * MiB,
                 WS_AB = 425 * MiB, WS_YA = 427 * MiB, WS_YB = 460 * MiB, WS_REC = 493 * MiB, WS_TMP = 493 * MiB, WS_MERGED = 560 * MiB,
                 WS_TMP2 = 594 * MiB, WS_XB = 637 * MiB, WS_GL = 670 * MiB, WS_END = 671 * MiB;
constexpr int REC_BYTES = 73728, REC_W = 0, REC_QD = 16384, REC_ATT = 32768, REC_KDT = 40960, REC_UT = 57344;
constexpr size_t O_Y = 0, O_GP = 16908288, O_CP = 21102592, O_GS = 21397504, O_CS = 88506368, O_VS = 93224960;

struct Args { const float* in[17]; float* out; unsigned char* ws; };

__device__ __forceinline__ float sigm(float x) { return __builtin_amdgcn_rcpf(1.0f + __expf(-x)); }
__device__ __forceinline__ float silu(float x) { return x * sigm(x); }
__device__ __forceinline__ unsigned pk2(float lo, float hi) { return pg8::cvt_pk_bf16(lo, hi); }
__device__ __forceinline__ float bflo(unsigned w) { return __uint_as_float(w << 16); }
__device__ __forceinline__ float bfhi(unsigned w) { return __uint_as_float(w & 0xffff0000u); }
__device__ __forceinline__ float bf1(bf16_t b) { return __uint_as_float((unsigned)b << 16); }
__device__ __forceinline__ bf16_t f2bf(float f) { return (bf16_t)(pk2(f, 0.f) & 0xffffu); }
__device__ __forceinline__ void unpack8(const u32x4 w, float* f) { f[0] = bflo(w.x); f[1] = bfhi(w.x); f[2] = bflo(w.y); f[3] = bfhi(w.y); f[4] = bflo(w.z); f[5] = bfhi(w.z); f[6] = bflo(w.w); f[7] = bfhi(w.w); }
__device__ __forceinline__ float wave_sum(float v) {
#pragma unroll
    for (int o = 1; o < 64; o <<= 1) v += __shfl_xor(v, o);
    return v;
}
__device__ __forceinline__ bf16x8 as_bf16x8(u32x4 w) { return __builtin_bit_cast(bf16x8, w); }

#define SCHED_FENCE() __builtin_amdgcn_sched_barrier(0)
#define LDS_BAR() do { asm volatile("s_waitcnt lgkmcnt(0)" ::: "memory"); __builtin_amdgcn_s_barrier(); asm volatile("" ::: "memory"); } while (0)
struct Epi1 {
    static constexpr bool PERM = true, AFTER_DRAIN = false, KEEP = false;
    bf16_t* P; float* AB;
    __device__ __forceinline__ void operator()(const f32x4 (&acc)[2][2][4][2], const Unit& u, int wr, int wc, int fr, int fq) const {
        const int row0 = u.pm * 256 + wr * 64 + fr;
        if (u.pn < 36) {
            const int col0 = u.pn * 256 + wc * 32 + 8 * fq;
#pragma unroll
            for (int ai = 0; ai < 2; ++ai)
#pragma unroll
                for (int m = 0; m < 4; ++m) { bf16_t* rowp = P + (size_t)(row0 + ai * 128 + m * 16) * NPROJ + col0;
#pragma unroll
                    for (int bj = 0; bj < 2; ++bj) { const f32x4 v0 = acc[ai][bj][m][0], v1 = acc[ai][bj][m][1];
                        u32x4 w; w.x = pk2(v0[0], v0[1]); w.y = pk2(v0[2], v0[3]); w.z = pk2(v1[0], v1[1]); w.w = pk2(v1[2], v1[3]);
                        *(u32x4*)(rowp + bj * 128) = w; } }
        } else if (wc == 0 && fq < 2) {
#pragma unroll
            for (int ai = 0; ai < 2; ++ai)
#pragma unroll
                for (int m = 0; m < 4; ++m) { float* rp = AB + (size_t)(row0 + ai * 128 + m * 16) * 16 + 8 * fq;
                    *(f32x4*)rp = acc[ai][0][m][0]; *(f32x4*)(rp + 4) = acc[ai][0][m][1]; }
        }
    }
};
constexpr int P4_DPM = (int)((WS_YB - WS_YA) / (256 * 2048)), P4_DPN = (int)((WS_WPB - WS_WPA) / (256 * 2048));
static_assert((WS_YB - WS_YA) % (256 * 2048) == 0 && (WS_WPB - WS_WPA) % (256 * 2048) == 0, "tile-aligned operand offsets");
struct PairOrder : pg8::StaticOrder {
    __device__ bool next(int i, Unit& u) const {
        if (i >= 2) return false;
        if (!pg8::StaticOrder::next(0, u)) return false;
        if (i == 1) { u.pm += P4_DPM; u.pn += P4_DPN; }
        return true;
    }
};
struct Epi2ab {
    static constexpr bool PERM = true, AFTER_DRAIN = false, KEEP = true;
    const bf16_t* P; bf16_t* MG;
    __device__ __forceinline__ bool keep(const Unit& u) const { return u.pm < P4_DPM; }
    __device__ __forceinline__ void operator()(f32x4 (&acc)[2][2][4][2], const Unit& u, int wr, int wc, int fr, int fq) const {
        if (u.pm < P4_DPM) {
            const int row0 = u.pm * 256 + wr * 64 + fr, col0 = u.pn * 256 + wc * 32 + 8 * fq;
#pragma unroll
            for (int ai = 0; ai < 2; ++ai) {
                u32x4 ga[4][2], gb[4][2];
#pragma unroll
                for (int m = 0; m < 4; ++m)
#pragma unroll
                    for (int bj = 0; bj < 2; ++bj) { const size_t r = (size_t)(row0 + ai * 128 + m * 16); ga[m][bj] = *(const u32x4*)(P + r * NPROJ + C_GA + col0 + bj * 128); gb[m][bj] = *(const u32x4*)(P + r * NPROJ + C_GB + col0 + bj * 128); }
#pragma unroll
                for (int m = 0; m < 4; ++m)
#pragma unroll
                    for (int bj = 0; bj < 2; ++bj) { float a8[8], b8[8]; unpack8(ga[m][bj], a8); unpack8(gb[m][bj], b8);
#pragma unroll
                        for (int j = 0; j < 4; ++j) {
                            acc[ai][bj][m][0][j] *= (1.0f + __expf(-fmaxf(b8[j], -30.f))) * __builtin_amdgcn_rcpf(1.0f + __expf(-a8[j]));
                            acc[ai][bj][m][1][j] *= (1.0f + __expf(-fmaxf(b8[4 + j], -30.f))) * __builtin_amdgcn_rcpf(1.0f + __expf(-a8[4 + j])); } }
            }
        } else {
            const int row0 = (u.pm - P4_DPM) * 256 + wr * 64 + fr, col0 = (u.pn - P4_DPN) * 256 + wc * 32 + 8 * fq;
#pragma unroll
            for (int ai = 0; ai < 2; ++ai) {
                u32x4 gb[4][2];
#pragma unroll
                for (int m = 0; m < 4; ++m)
#pragma unroll
                    for (int bj = 0; bj < 2; ++bj) gb[m][bj] = *(const u32x4*)(P + (size_t)(row0 + ai * 128 + m * 16) * NPROJ + C_GB + col0 + bj * 128);
#pragma unroll
                for (int m = 0; m < 4; ++m) { const size_t r = (size_t)(row0 + ai * 128 + m * 16);
#pragma unroll
                    for (int bj = 0; bj < 2; ++bj) { float b8[8]; unpack8(gb[m][bj], b8); float sb[8];
#pragma unroll
                        for (int j = 0; j < 8; ++j) sb[j] = __builtin_amdgcn_rcpf(1.0f + __expf(-fmaxf(b8[j], -30.f)));
                        const f32x4 v0 = acc[ai][bj][m][0], v1 = acc[ai][bj][m][1];
                        u32x4 w; w.x = pk2(v0[0] * sb[0], v0[1] * sb[1]); w.y = pk2(v0[2] * sb[2], v0[3] * sb[3]); w.z = pk2(v1[0] * sb[4], v1[1] * sb[5]); w.w = pk2(v1[2] * sb[6], v1[3] * sb[7]);
                        *(u32x4*)(MG + r * D + col0 + bj * 128) = w; } }
            }
        }
    }
};
struct Epi3 {
    static constexpr bool PERM = true, AFTER_DRAIN = false, KEEP = false;
    bf16_t* C;
    __device__ __forceinline__ void operator()(const f32x4 (&acc)[2][2][4][2], const Unit& u, int wr, int wc, int fr, int fq) const {
        const int row0 = u.pm * 256 + wr * 64 + fr, col0 = u.pn * 256 + wc * 32 + 8 * fq;
#pragma unroll
        for (int ai = 0; ai < 2; ++ai)
#pragma unroll
            for (int m = 0; m < 4; ++m) { bf16_t* rowp = C + (size_t)(row0 + ai * 128 + m * 16) * D + col0;
#pragma unroll
                for (int bj = 0; bj < 2; ++bj) { const f32x4 v0 = acc[ai][bj][m][0], v1 = acc[ai][bj][m][1];
                    u32x4 w; w.x = pk2(v0[0], v0[1]); w.y = pk2(v0[2], v0[3]); w.z = pk2(v1[0], v1[1]); w.w = pk2(v1[2], v1[3]);
                    *(u32x4*)(rowp + bj * 128) = w; } }
    }
};
__device__ __forceinline__ void p0_transpose_item(const float* W, int nsrc, bf16_t* WT, float* scr, int item, int nblk, int lane, int mode) {
    const int kb = item / nblk, nb = item % nblk, k0 = 64 * kb, n0 = 32 * nb;
    const int n = n0 + (lane & 31);
    int sc = n;
    if (mode == 1) sc = (n < 7168) ? n : (n < 9216 ? n + 16 : (n < 9232 ? n - 9216 + 7168 : -1));
#pragma unroll 1
    for (int hh = 0; hh < 2; ++hh) {
        float wv[16];
#pragma unroll
        for (int i = 0; i < 16; ++i) { const int kk = 2 * (hh * 16 + i) + (lane >> 5); wv[i] = (sc >= 0) ? W[(size_t)(k0 + kk) * nsrc + sc] : 0.f; }
        SCHED_FENCE();
#pragma unroll
        for (int i = 0; i < 16; ++i) { const int kk = 2 * (hh * 16 + i) + (lane >> 5); scr[kk * 33 + (lane & 31)] = wv[i]; }
    }
    asm volatile("s_waitcnt lgkmcnt(0)" ::: "memory");
    const int c = lane & 7;
#pragma unroll
    for (int j = 0; j < 4; ++j) { const int nn = (lane >> 3) + 8 * j; const float* s = scr + (8 * c) * 33 + nn;
        u32x4 o; o.x = pk2(s[0 * 33], s[1 * 33]); o.y = pk2(s[2 * 33], s[3 * 33]); o.z = pk2(s[4 * 33], s[5 * 33]); o.w = pk2(s[6 * 33], s[7 * 33]);
        *(u32x4*)(WT + (size_t)(n0 + nn) * 1024 + k0 + 8 * c) = o; }
    asm volatile("s_waitcnt lgkmcnt(0)" ::: "memory");
}
__device__ __forceinline__ void rms_row_to_bf16(const float* xrow, const float* g, bf16_t* orow, int lane) {
    const f32x4* xr = (const f32x4*)xrow + lane; const f32x4* gr = (const f32x4*)g + lane;
    f32x4 v[4]; float s = 0.f;
#pragma unroll
    for (int j = 0; j < 4; ++j) { v[j] = xr[64 * j]; s += (v[j][0] * v[j][0] + v[j][1] * v[j][1]) + (v[j][2] * v[j][2] + v[j][3] * v[j][3]); }
    const float rstd = rsqrtf(wave_sum(s) * (1.f / D) + EPS);
    u32x2* o8 = (u32x2*)orow + lane;
#pragma unroll
    for (int j = 0; j < 4; ++j) { const f32x4 gg = gr[64 * j]; u32x2 w; w.x = pk2(v[j][0] * rstd * gg[0], v[j][1] * rstd * gg[1]); w.y = pk2(v[j][2] * rstd * gg[2], v[j][3] * rstd * gg[3]); o8[64 * j] = w; }
}
__device__ __forceinline__ void phase_weights(const Args& a, unsigned char* lds, int lw, int wgi, int nwg, int tid) {
    asm volatile("" : "+v"(tid));
    const int wave = tid >> 6, lane = tid & 63; const int gw = wgi * 8 + wave, NGW = nwg * 8;
    float* scr = (float*)(lds + wave * 16384);
    asm volatile("" : "+v"(tid));
    constexpr int I_IN = 16 * (NW1 / 32), I_SQ = 16 * 32, PER_L = I_IN + 3 * I_SQ;
    for (int it = gw; it < PER_L; it += NGW) {
        const int l = lw; int r = it;
        if (r < I_IN) { p0_transpose_item(a.in[5] + (size_t)l * D * INDIM, INDIM, (bf16_t*)(a.ws + WS_W1T) + (size_t)l * NW1 * D, scr, r, NW1 / 32, lane, 1); continue; } r -= I_IN;
        if (r < I_SQ) { p0_transpose_item(a.in[13] + (size_t)l * D * D, D, (bf16_t*)(a.ws + WS_WPA) + (size_t)l * D * D, scr, r, 32, lane, 0); continue; } r -= I_SQ;
        if (r < I_SQ) { p0_transpose_item(a.in[14] + (size_t)l * D * D, D, (bf16_t*)(a.ws + WS_WPB) + (size_t)l * D * D, scr, r, 32, lane, 0); continue; } r -= I_SQ;
        p0_transpose_item(a.in[15] + (size_t)l * D * D, D, (bf16_t*)(a.ws + WS_WOUT) + (size_t)l * D * D, scr, r, 32, lane, 0);
    }
}
__device__ __forceinline__ void phase_prologue(const Args& a, unsigned char* lds, int wg, int G, int tid) {
    asm volatile("" : "+v"(tid));
    const int wave = tid >> 6, lane = tid & 63; const int gw = wg * 8 + wave, NGW = G * 8;
    phase_weights(a, lds, 0, wg, G, tid);
    bf16_t* H = (bf16_t*)(a.ws + WS_H);
    for (int m = gw; m < MP; m += NGW) {
        if (m < TT) { const float* xr = (m < TP) ? a.in[0] + (size_t)m * D : a.in[1] + (size_t)(m - TP) * D; rms_row_to_bf16(xr, a.in[4], H + (size_t)m * D, lane); }
        else { u32x4 z = {0u, 0u, 0u, 0u}; u32x4* o = (u32x4*)(H + (size_t)m * D) + lane; o[0] = z; o[64] = z; }
    }
}
__device__ __forceinline__ void phase_residual(const Args& a, int l, int wg, int G, int tid) {
    asm volatile("" : "+v"(tid));
    const int wave = tid >> 6, lane = tid & 63; const int gw = wg * 8 + wave, NGW = G * 8;
    const bf16_t* OUT = (const bf16_t*)(a.ws + WS_TMP); bf16_t* H = (bf16_t*)(a.ws + WS_H); bf16_t* XB = (bf16_t*)(a.ws + WS_XB);
    const f32x4* pgp = (const f32x4*)(a.in[16] + (size_t)l * D) + lane;
    const f32x4* ngp = (const f32x4*)(a.in[4] + (size_t)((l + 1 < DEPTH) ? l + 1 : l) * D) + lane;
    f32x4 pg[4], ng[4];
#pragma unroll
    for (int j = 0; j < 4; ++j) { pg[j] = pgp[64 * j]; ng[j] = ngp[64 * j]; }
    for (int m0 = gw; m0 < TT; m0 += 2 * NGW) {
        f32x4 v[2][4], x[2][4]; float s[2], s2[2];
#pragma unroll
        for (int r = 0; r < 2; ++r) { const int m = (m0 + r * NGW < TT) ? m0 + r * NGW : m0;
            const u32x2* orow = (const u32x2*)(OUT + (size_t)m * D) + lane;
#pragma unroll
            for (int j = 0; j < 4; ++j) { const u32x2 ow = orow[64 * j]; v[r][j] = (f32x4){bflo(ow.x), bfhi(ow.x), bflo(ow.y), bfhi(ow.y)}; }
            if (l == 0) { const float* xs = (m < TP) ? a.in[0] + (size_t)m * D : a.in[1] + (size_t)(m - TP) * D; const f32x4* xr = (const f32x4*)xs + lane;
#pragma unroll
                for (int j = 0; j < 4; ++j) x[r][j] = xr[64 * j];
            } else { const u32x2* xr = (const u32x2*)(XB + (size_t)m * D) + lane;
#pragma unroll
                for (int j = 0; j < 4; ++j) { const u32x2 xw = xr[64 * j]; x[r][j] = (f32x4){bflo(xw.x), bfhi(xw.x), bflo(xw.y), bfhi(xw.y)}; } } }
#pragma unroll
        for (int r = 0; r < 2; ++r) { s[r] = 0.f;
#pragma unroll
            for (int j = 0; j < 4; ++j) s[r] += (v[r][j][0] * v[r][j][0] + v[r][j][1] * v[r][j][1]) + (v[r][j][2] * v[r][j][2] + v[r][j][3] * v[r][j][3]); }
#pragma unroll
        for (int o = 1; o < 64; o <<= 1) { s[0] += __shfl_xor(s[0], o); s[1] += __shfl_xor(s[1], o); }
#pragma unroll
        for (int r = 0; r < 2; ++r) { const float rs = rsqrtf(s[r] * (1.f / D) + EPS); s2[r] = 0.f;
#pragma unroll
            for (int j = 0; j < 4; ++j) { const f32x4 g = pg[j]; x[r][j] = x[r][j] + v[r][j] * rs * g; s2[r] += (x[r][j][0] * x[r][j][0] + x[r][j][1] * x[r][j][1]) + (x[r][j][2] * x[r][j][2] + x[r][j][3] * x[r][j][3]); } }
#pragma unroll
        for (int o = 1; o < 64; o <<= 1) { s2[0] += __shfl_xor(s2[0], o); s2[1] += __shfl_xor(s2[1], o); }
#pragma unroll
        for (int r = 0; r < 2; ++r) { const int m = m0 + r * NGW;
            if (m < TT) {
                if (l + 1 == DEPTH) { f32x4* xo = (f32x4*)(a.out + O_Y + (size_t)m * D) + lane;
#pragma unroll
                    for (int j = 0; j < 4; ++j) xo[64 * j] = x[r][j];
                } else { u32x2* xo = (u32x2*)(XB + (size_t)m * D) + lane;
#pragma unroll
                    for (int j = 0; j < 4; ++j) { u32x2 w; w.x = pk2(x[r][j][0], x[r][j][1]); w.y = pk2(x[r][j][2], x[r][j][3]); xo[64 * j] = w; } }
                if (l + 1 < DEPTH) { const float r2 = rsqrtf(s2[r] * (1.f / D) + EPS); u32x2* o8 = (u32x2*)(H + (size_t)m * D) + lane;
#pragma unroll
                    for (int j = 0; j < 4; ++j) { const f32x4 g = ng[j]; u32x2 w; w.x = pk2(x[r][j][0] * r2 * g[0], x[r][j][1] * r2 * g[1]); w.y = pk2(x[r][j][2] * r2 * g[2], x[r][j][3] * r2 * g[3]); o8[64 * j] = w; } }
            } }
    }
}
__device__ __forceinline__ void phase_vrstd(const Args& a, int wg, int G, int tid) {
    asm volatile("" : "+v"(tid));
    const int wave = tid >> 6, lane = tid & 63; const bf16_t* P = (const bf16_t*)(a.ws + WS_PROJ); float* R = (float*)(a.ws + WS_RSTDV);
    for (int m = wg * 8 + wave; m < TP; m += G * 8) {
        const u32x4* vp = (const u32x4*)(P + (size_t)m * NPROJ + C_V) + lane; float f[8], s = 0.f;
        unpack8(vp[0], f);
#pragma unroll
        for (int j = 0; j < 8; ++j) s += f[j] * f[j];
        unpack8(vp[64], f);
#pragma unroll
        for (int j = 0; j < 8; ++j) s += f[j] * f[j];
        s = wave_sum(s);
        if (lane == 0) R[m] = rsqrtf(s * (1.f / D) + EPS);
    }
}
__device__ __forceinline__ void task_gmlp_prompt(const Args& a, int l, unsigned char* lds, int task, int tid) {
    asm volatile("" : "+v"(tid));
    const int chunk = task >> 3, g = task & 7, r0 = chunk * 128;
    const int wave = tid >> 6, lane = tid & 63, l15 = lane & 15, q = lane >> 4;
    const bf16_t* P = (const bf16_t*)(a.ws + WS_PROJ); bf16_t* YA = (bf16_t*)(a.ws + WS_YA); const float* R = (const float*)(a.ws + WS_RSTDV);
    bf16_t* WsA = (bf16_t*)(lds + 1024);
    bf16_t* VT = (bf16_t*)(lds + 1024 + 34816);
    float* MIX = (float*)(lds + 1024 + 2 * 34816);
    const int it_ = tid >> 4, icg8 = (tid & 15) * 8;
    const float* Ws = a.in[7] + ((size_t)l * 8 + g) * 128 * 128;
    f32x4 wv[8]; u32x4 vv[4], uu[4], zz[4]; float rs[4];
#pragma unroll
    for (int i = 0; i < 8; ++i) { const int idx = tid + 512 * i; wv[i] = *(const f32x4*)(Ws + (idx >> 5) * 128 + (idx & 31) * 4); }
#pragma unroll
    for (int i = 0; i < 4; ++i) { const size_t pr = (size_t)(r0 + it_ + 32 * i) * NPROJ + g * 128 + icg8;
        vv[i] = *(const u32x4*)(P + pr + C_V); uu[i] = *(const u32x4*)(P + pr + C_U); zz[i] = *(const u32x4*)(P + pr + C_Z); rs[i] = R[r0 + it_ + 32 * i]; }
    float gn[8];
#pragma unroll
    for (int j = 0; j < 8; ++j) gn[j] = a.in[6][(size_t)l * D + g * 128 + icg8 + j];
#pragma unroll
    for (int i = 0; i < 8; ++i) { const int idx = tid + 512 * i, t = idx >> 5, s4 = (idx & 31) * 4; const f32x4 w = wv[i];
        u32x2 o; o.x = pk2(s4 <= t ? w[0] : 0.f, s4 + 1 <= t ? w[1] : 0.f); o.y = pk2(s4 + 2 <= t ? w[2] : 0.f, s4 + 3 <= t ? w[3] : 0.f);
        *(u32x2*)(WsA + t * 136 + s4) = o; }
#pragma unroll
    for (int i = 0; i < 4; ++i) { const int sidx = it_ + 32 * i; float f[8]; unpack8(vv[i], f); const int sw = sidx ^ icg8;
#pragma unroll
        for (int j = 0; j < 8; ++j) VT[(icg8 + j) * 136 + sw] = f2bf(f[j] * rs[i] * gn[j]); }
    LDS_BAR();
    {
        f32x4 acc[8];
#pragma unroll
        for (int c = 0; c < 8; ++c) acc[c] = (f32x4){0.f, 0.f, 0.f, 0.f};
        const int nks = (wave >> 1) + 1;
        for (int ks = 0; ks < nks; ++ks) {
            const bf16x8 af = *(const bf16x8*)(WsA + (wave * 16 + l15) * 136 + ks * 32 + q * 8); bf16x8 bfr[8];
#pragma unroll
            for (int c = 0; c < 8; ++c) { const int cc = c * 16 + l15; bfr[c] = *(const bf16x8*)(VT + cc * 136 + ((ks * 32 + q * 8) ^ ((cc >> 3) * 8))); }
            SCHED_FENCE();
#pragma unroll
            for (int c = 0; c < 8; ++c) acc[c] = __builtin_amdgcn_mfma_f32_16x16x32_bf16(af, bfr[c], acc[c], 0, 0, 0);
            SCHED_FENCE();
        }
        const float* bs = a.in[8] + ((size_t)l * 8 + g) * 128;
#pragma unroll
        for (int j = 0; j < 4; ++j) { const int t = wave * 16 + q * 4 + j; const float b = bs[t];
#pragma unroll
            for (int c = 0; c < 8; ++c) MIX[t * 132 + c * 16 + l15] = acc[c][j] + b; }
    }
    LDS_BAR();
#pragma unroll
    for (int i = 0; i < 4; ++i) { const int t = it_ + 32 * i;
        float u[8], z[8]; unpack8(uu[i], u); unpack8(zz[i], z);
        const f32x4 m0 = *(const f32x4*)(MIX + t * 132 + icg8), m1 = *(const f32x4*)(MIX + t * 132 + icg8 + 4);
        u32x4 o; o.x = pk2(u[0] * m0[0] * silu(z[0]), u[1] * m0[1] * silu(z[1])); o.y = pk2(u[2] * m0[2] * silu(z[2]), u[3] * m0[3] * silu(z[3]));
        o.z = pk2(u[4] * m1[0] * silu(z[4]), u[5] * m1[1] * silu(z[5])); o.w = pk2(u[6] * m1[2] * silu(z[6]), u[7] * m1[3] * silu(z[7]));
        *(u32x4*)(YA + (size_t)(r0 + t) * D + g * 128 + icg8) = o; }
    LDS_BAR();
}
__device__ __forceinline__ void task_gmlp_sample(const Args& a, int l, int task, int tid) {
    asm volatile("" : "+v"(tid));
    const int wave = tid >> 6, lane = tid & 63; const int b = task * 8 + wave, r = TP + b;
    const bf16_t* P = (const bf16_t*)(a.ws + WS_PROJ); bf16_t* YA = (bf16_t*)(a.ws + WS_YA);
    const size_t pr = (size_t)r * NPROJ;
    float v[16]; unpack8(*(const u32x4*)(P + pr + C_V + lane * 16), v); unpack8(*(const u32x4*)(P + pr + C_V + lane * 16 + 8), v + 8);
    float s = 0.f;
#pragma unroll
    for (int j = 0; j < 16; ++j) s += v[j] * v[j];
    const float rs = rsqrtf(wave_sum(s) * (1.f / D) + EPS);
    const int g = lane >> 3;
    const float w00 = a.in[7][((size_t)l * 8 + g) * 128 * 128], b0 = a.in[8][((size_t)l * 8 + g) * 128];
    const float* gn = a.in[6] + (size_t)l * D + lane * 16;
    float u[16], z[16]; unpack8(*(const u32x4*)(P + pr + C_U + lane * 16), u); unpack8(*(const u32x4*)(P + pr + C_U + lane * 16 + 8), u + 8);
    unpack8(*(const u32x4*)(P + pr + C_Z + lane * 16), z); unpack8(*(const u32x4*)(P + pr + C_Z + lane * 16 + 8), z + 8);
    float* vo = a.out + O_VS + ((size_t)l * DB + b) * D + lane * 16; float y[16];
#pragma unroll
    for (int j = 0; j < 16; ++j) { const float vn = v[j] * rs * gn[j]; vo[j] = vn; y[j] = u[j] * (w00 * vn + b0) * silu(z[j]); }
    u32x4 o0, o1; o0.x = pk2(y[0], y[1]); o0.y = pk2(y[2], y[3]); o0.z = pk2(y[4], y[5]); o0.w = pk2(y[6], y[7]);
    o1.x = pk2(y[8], y[9]); o1.y = pk2(y[10], y[11]); o1.z = pk2(y[12], y[13]); o1.w = pk2(y[14], y[15]);
    *(u32x4*)(YA + (size_t)r * D + lane * 16) = o0; *(u32x4*)(YA + (size_t)r * D + lane * 16 + 8) = o1;
}
__device__ __forceinline__ void task_delta_sample(const Args& a, int l, unsigned char* lds, int task, int tid) {
    asm volatile("" : "+v"(tid));
    const int b = task >> 3, h = task & 7, r = TP + b; const int wave = tid >> 6, lane = tid & 63;
    const bf16_t* P = (const bf16_t*)(a.ws + WS_PROJ); const float* AB = (const float*)(a.ws + WS_AB); bf16_t* YB = (bf16_t*)(a.ws + WS_YB);
    float* qkv = (float*)lds;
    float* sc = qkv + 384;
    float* part = qkv + 512;
    float* red = part + 1024;
    const int vc = tid & 127, kq = tid >> 7;
    const float* S = a.in[2] + (((size_t)l * DB + b) * 8 + h) * 16384 + (size_t)(kq * 32) * 128 + vc;
    float Sr[32];
#pragma unroll
    for (int i = 0; i < 32; ++i) Sr[i] = S[i * 128];
    const float av = AB[(size_t)r * 16 + h], bv = AB[(size_t)r * 16 + 8 + h];
    const float zb = bf1(P[(size_t)r * NPROJ + C_ZB + h * 128 + vc]);
    if (tid < 384) {
        const int tz = tid >> 7, ch = tid & 127, col = tz * 1024 + h * 128 + ch;
        const float* cw = a.in[9] + (size_t)l * 4 * CONVD + col; const float* sb = a.in[3] + ((size_t)l * DB + b) * 3 * CONVD + col;
        const float xn = bf1(P[(size_t)r * NPROJ + C_QKV + col]);
        const float x0 = sb[0], x1 = sb[CONVD], x2 = sb[2 * CONVD];
        qkv[tid] = silu(cw[0] * x0 + cw[CONVD] * x1 + cw[2 * CONVD] * x2 + cw[3 * CONVD] * xn);
        float* co = a.out + O_CS + ((size_t)l * DB + b) * 3 * CONVD + col; co[0] = x1; co[CONVD] = x2; co[2 * CONVD] = xn;
    }
    LDS_BAR();
    if (wave < 3) {
        const float q0 = qkv[lane], q1 = qkv[64 + lane], k0 = qkv[128 + lane], k1 = qkv[192 + lane];
        float s = (wave == 0) ? q0 * q0 + q1 * q1 : (wave == 1 ? k0 * k0 + k1 * k1 : q0 * k0 + q1 * k1);
        s = wave_sum(s);
        if (lane == 0) sc[wave] = s;
    }
    LDS_BAR();
    const float qs = rsqrtf(sc[0] + EPS) * 0.08838834764831845f, ks = rsqrtf(sc[1] + EPS), qk = sc[2] * qs * ks;
    const float xs = av + a.in[11][l * 8 + h]; const float sp = (xs > 20.f) ? xs : log1pf(__expf(xs));
    const float gg = -__expf(a.in[10][l * 8 + h]) * sp, eg = __expf(gg), beta = sigm(bv);
    float pk = 0.f, pq = 0.f;
#pragma unroll
    for (int i = 0; i < 32; ++i) { const float kn = qkv[128 + kq * 32 + i] * ks, qn = qkv[kq * 32 + i] * qs; pk += kn * Sr[i]; pq += qn * Sr[i]; }
    part[kq * 128 + vc] = pk; part[512 + kq * 128 + vc] = pq;
    LDS_BAR();
    const float kS = part[vc] + part[128 + vc] + part[256 + vc] + part[384 + vc], qS = part[512 + vc] + part[640 + vc] + part[768 + vc] + part[896 + vc];
    const float vnew = beta * (qkv[256 + vc] - eg * kS), o = eg * qS + qk * vnew;
    float* So = a.out + O_GS + (((size_t)l * DB + b) * 8 + h) * 16384 + (size_t)(kq * 32) * 128 + vc;
#pragma unroll
    for (int i = 0; i < 32; ++i) So[i * 128] = eg * Sr[i] + qkv[128 + kq * 32 + i] * ks * vnew;
    if (kq == 0) { const float s = wave_sum(o * o); if (lane == 0) red[wave] = s; }
    LDS_BAR();
    if (kq == 0) {
        const float rs = rsqrtf((red[0] + red[1]) * (1.f / 128.f) + EPS);
        YB[(size_t)r * D + h * 128 + vc] = f2bf(o * rs * a.in[12][l * 128 + vc] * silu(zb));
    }
    LDS_BAR();
}
__device__ __forceinline__ void task_prep2(const Args& a, int l, unsigned char* lds, int task, int tid) {
    asm volatile("" : "+v"(tid));
    typedef float f32x2 __attribute__((ext_vector_type(2)));
    const int p = task & 15, h = (task >> 4) & 7, b = task >> 7; const int wave = tid >> 6, lane = tid & 63, l15 = lane & 15, q = lane >> 4;
    const bf16_t* P = (const bf16_t*)(a.ws + WS_PROJ); const float* AB = (const float*)(a.ws + WS_AB);
    const int ctask0 = (b * 8 + h) * 32 + 2 * p;
    bf16_t* Qb = (bf16_t*)lds; bf16_t* Kb = Qb + 128 * 136; bf16_t* Vb = Kb + 128 * 136;
    float* TTm = (float*)(lds + 104448);
    float* gc = (float*)(lds + 139264); float* beta = gc + 128; float* eg = beta + 128;
    const int tok0 = b * SEQ + p * 128;
    float av = 0.f, bv = 0.f;
    if (tid < 128) { av = AB[(size_t)(tok0 + tid) * 16 + h]; bv = AB[(size_t)(tok0 + tid) * 16 + 8 + h]; }
#pragma unroll 1
    for (int half = 0; half < 2; ++half) {
        if (tid < 384) {
            const int tz = tid >> 7, cg8 = (tid & 15) * 8, rb = (tid >> 4) & 7; const int col = tz * 1024 + h * 128 + cg8;
            const float* cw = a.in[9] + (size_t)l * 4 * CONVD + col;
            u32x4 xr[11];
#pragma unroll
            for (int k = 0; k < 11; ++k) { const int tp = p * 128 + half * 64 + rb * 8 - 3 + k;
                xr[k] = (tp >= 0) ? *(const u32x4*)(P + (size_t)(b * SEQ + tp) * NPROJ + C_QKV + col) : (u32x4){0u, 0u, 0u, 0u}; }
            f32x4 w0[4], w1[4];
#pragma unroll
            for (int ii = 0; ii < 4; ++ii) { w0[ii] = *(const f32x4*)(cw + ii * CONVD); w1[ii] = *(const f32x4*)(cw + ii * CONVD + 4); }
#pragma unroll
            for (int rr = 0; rr < 8; ++rr) {
                float acc[8];
#pragma unroll
                for (int j = 0; j < 8; ++j) acc[j] = 0.f;
#pragma unroll
                for (int ii = 0; ii < 4; ++ii) { float x[8]; unpack8(xr[rr + ii], x);
#pragma unroll
                    for (int j = 0; j < 4; ++j) { acc[j] += w0[ii][j] * x[j]; acc[4 + j] += w1[ii][j] * x[4 + j]; } }
                u32x4 o; o.x = pk2(silu(acc[0]), silu(acc[1])); o.y = pk2(silu(acc[2]), silu(acc[3])); o.z = pk2(silu(acc[4]), silu(acc[5])); o.w = pk2(silu(acc[6]), silu(acc[7]));
                *(u32x4*)(Qb + tz * (128 * 136) + (half * 64 + rb * 8 + rr) * 136 + cg8) = o;
            }
        }
    }
    LDS_BAR();
    {
        const int rowid = tid >> 1, part = tid & 1; bf16_t* pr = Qb + (rowid >> 7) * (128 * 136) + (rowid & 127) * 136 + part * 64;
        u32x4 w[8]; float ss = 0.f;
#pragma unroll
        for (int i = 0; i < 8; ++i) { w[i] = *(const u32x4*)(pr + 8 * i); float f[8]; unpack8(w[i], f);
#pragma unroll
            for (int j = 0; j < 8; ++j) ss += f[j] * f[j]; }
        ss += __shfl_xor(ss, 1);
        const float scl = rsqrtf(ss + EPS) * ((rowid < 128) ? 0.08838834764831845f : 1.0f);
#pragma unroll
        for (int i = 0; i < 8; ++i) { float f[8]; unpack8(w[i], f); u32x4 o; o.x = pk2(f[0] * scl, f[1] * scl); o.y = pk2(f[2] * scl, f[3] * scl); o.z = pk2(f[4] * scl, f[5] * scl); o.w = pk2(f[6] * scl, f[7] * scl);
            *(u32x4*)(pr + 8 * i) = o; }
    }
    if (tid < 128) {
        const float xs = av + a.in[11][l * 8 + h]; const float sp = (xs > 20.f) ? xs : log1pf(__expf(xs));
        float g = -__expf(a.in[10][l * 8 + h]) * sp;
#pragma unroll
        for (int o = 1; o < 64; o <<= 1) { const float t = __shfl_up(g, o); if (lane >= o) g += t; }
        gc[tid] = g; beta[tid] = sigm(bv); eg[tid] = __expf(g);
        if (lane == 63) ((float*)(a.ws + WS_GL))[ctask0 + wave] = __expf(g);
    }
    LDS_BAR();
    {
        const int c = wave & 1, isq = (wave >> 1) & 1, ip = wave >> 2; const bf16_t* Asrc = isq ? Qb : Kb;
        bf16x8 af[2][4], bfr[4][4];
#pragma unroll
        for (int i2 = 0; i2 < 2; ++i2)
#pragma unroll
            for (int ks = 0; ks < 4; ++ks) af[i2][ks] = *(const bf16x8*)(Asrc + (c * 64 + (2 * ip + i2) * 16 + l15) * 136 + ks * 32 + q * 8);
#pragma unroll
        for (int jt = 0; jt < 4; ++jt)
#pragma unroll
            for (int ks = 0; ks < 4; ++ks) bfr[jt][ks] = *(const bf16x8*)(Kb + (c * 64 + jt * 16 + l15) * 136 + ks * 32 + q * 8);
        SCHED_FENCE();
        f32x4 acc[2][4];
#pragma unroll
        for (int i2 = 0; i2 < 2; ++i2)
#pragma unroll
            for (int jt = 0; jt < 4; ++jt) acc[i2][jt] = (f32x4){0.f, 0.f, 0.f, 0.f};
#pragma unroll
        for (int ks = 0; ks < 4; ++ks)
#pragma unroll
            for (int i2 = 0; i2 < 2; ++i2)
#pragma unroll
                for (int jt = 0; jt < 4; ++jt) acc[i2][jt] = __builtin_amdgcn_mfma_f32_16x16x32_bf16(af[i2][ks], bfr[jt][ks], acc[i2][jt], 0, 0, 0);
        bf16_t* ATT = (bf16_t*)(a.ws + WS_REC + (size_t)(ctask0 + c) * REC_BYTES + REC_ATT); float* TTc = TTm + c * (64 * 68);
#pragma unroll
        for (int i2 = 0; i2 < 2; ++i2)
#pragma unroll
            for (int jt = 0; jt < 4; ++jt)
#pragma unroll
                for (int jj = 0; jj < 4; ++jj) { const int i = (2 * ip + i2) * 16 + q * 4 + jj, j = jt * 16 + l15; const float dg = gc[c * 64 + i] - gc[c * 64 + j];
                    if (isq) { const float v = (j <= i) ? acc[i2][jt][jj] * __expf(dg) : 0.f; ATT[i * 64 + j] = f2bf(v); }
                    else if (j < i) TTc[j * 68 + i] = beta[c * 64 + i] * acc[i2][jt][jj] * __expf(dg); }
    }
    LDS_BAR();
    {
        const int c = wave >> 2, col = tid & 255; int vz = 0; asm volatile("" : "+v"(vz));
        const float* betav = beta + c * 64 + vz; const float* egv = eg + c * 64 + vz; const LAS float* TTl = (const LAS float*)TTm + c * (64 * 68) + vz;
        unsigned char* rec = a.ws + WS_REC + (size_t)(ctask0 + c) * REC_BYTES;
        f32x2 r2[32];
        if (col < 128) {
#pragma unroll
            for (int k = 0; k < 32; ++k) r2[k] = (f32x2){bf1(Vb[(c * 64 + 2 * k) * 136 + col]) * betav[2 * k], bf1(Vb[(c * 64 + 2 * k + 1) * 136 + col]) * betav[2 * k + 1]};
        } else {
#pragma unroll
            for (int k = 0; k < 32; ++k) r2[k] = (f32x2){bf1(Kb[(c * 64 + 2 * k) * 136 + col - 128]) * betav[2 * k] * egv[2 * k], bf1(Kb[(c * 64 + 2 * k + 1) * 136 + col - 128]) * betav[2 * k + 1] * egv[2 * k + 1]};
        }
        f32x4 tb[2][16];
#pragma unroll
        for (int g = 0; g < 16; ++g) tb[0][g] = *(const volatile LAS f32x4*)(TTl + 4 * g);
#pragma unroll
        for (int j = 0; j < 63; ++j) {
            if (j + 1 < 63) {
#pragma unroll
                for (int g = ((j + 2) >> 2); g < 16; ++g) tb[(j + 1) & 1][g] = *(const volatile LAS f32x4*)(TTl + (j + 1) * 68 + 4 * g);
            }
            const float xj = (j & 1) ? r2[j >> 1].y : r2[j >> 1].x; const f32x2 xj2 = {xj, xj};
#pragma unroll
            for (int g = ((j + 1) >> 2); g < 16; ++g) { const f32x4 t4 = tb[j & 1][g]; const int i4 = 4 * g;
#pragma unroll
                for (int pp = 0; pp < 2; ++pp) { const int i0 = i4 + 2 * pp;
                    if (i0 > j) r2[i0 >> 1] -= (f32x2){t4[2 * pp], t4[2 * pp + 1]} * xj2;
                    else if (i0 + 1 > j) r2[i0 >> 1].y -= t4[2 * pp + 1] * xj; } } }
        if (col < 128) { bf16_t* UT = (bf16_t*)(rec + REC_UT) + col * 64;
#pragma unroll
            for (int i = 0; i < 8; ++i) { u32x4 w; w.x = pk2(r2[4 * i].x, r2[4 * i].y); w.y = pk2(r2[4 * i + 1].x, r2[4 * i + 1].y); w.z = pk2(r2[4 * i + 2].x, r2[4 * i + 2].y); w.w = pk2(r2[4 * i + 3].x, r2[4 * i + 3].y);
                *(u32x4*)(UT + 8 * i) = w; }
        } else { bf16_t* W = (bf16_t*)(rec + REC_W) + (col - 128);
#pragma unroll
            for (int k = 0; k < 32; ++k) { W[(2 * k) * 128] = f2bf(-r2[k].x); W[(2 * k + 1) * 128] = f2bf(-r2[k].y); } }
    }
#pragma unroll
    for (int i = 0; i < 4; ++i) { const int item = tid + 512 * i, tokr = item >> 4, cg8 = (item & 15) * 8, c = tokr >> 6, t = tokr & 63; const float e = eg[tokr];
        float f[8]; unpack8(*(const u32x4*)(Qb + tokr * 136 + cg8), f);
        u32x4 w; w.x = pk2(f[0] * e, f[1] * e); w.y = pk2(f[2] * e, f[3] * e); w.z = pk2(f[4] * e, f[5] * e); w.w = pk2(f[6] * e, f[7] * e);
        *(u32x4*)((bf16_t*)(a.ws + WS_REC + (size_t)(ctask0 + c) * REC_BYTES + REC_QD) + t * 128 + cg8) = w; }
#pragma unroll
    for (int i = 0; i < 4; ++i) { const int item = tid + 512 * i, d = item & 127, tg = (item >> 7) & 7, c = item >> 10; const float gl = gc[c * 64 + 63]; float v[8];
#pragma unroll
        for (int jj = 0; jj < 8; ++jj) v[jj] = bf1(Kb[(c * 64 + tg * 8 + jj) * 136 + d]) * __expf(gl - gc[c * 64 + tg * 8 + jj]);
        u32x4 w; w.x = pk2(v[0], v[1]); w.y = pk2(v[2], v[3]); w.z = pk2(v[4], v[5]); w.w = pk2(v[6], v[7]);
        *(u32x4*)((bf16_t*)(a.ws + WS_REC + (size_t)(ctask0 + c) * REC_BYTES + REC_KDT) + d * 64 + tg * 8) = w; }
    LDS_BAR();
}
__device__ __forceinline__ void task_scan(const Args& a, int l, unsigned char* lds, int task, int tid) {
    asm volatile("" : "+v"(tid));
    const int h = task & 7, b = task >> 3; const int wave = tid >> 6, lane = tid & 63, l15 = lane & 15, q = lane >> 4;
    const int rt = wave & 3, cb = (wave >> 2) * 4;
    const bf16_t* P = (const bf16_t*)(a.ws + WS_PROJ); bf16_t* YB = (bf16_t*)(a.ws + WS_YB); const float* GL = (const float*)(a.ws + WS_GL);
    bf16_t* ST0 = (bf16_t*)lds; bf16_t* ST1 = (bf16_t*)(lds + 34816); bf16_t* VT = (bf16_t*)(lds + 69632); float* RED = (float*)(lds + 88064);
    bf16_t* OT0 = (bf16_t*)(lds + 88576); bf16_t* OT1 = (bf16_t*)(lds + 88576 + 17408);
    for (int i = tid; i < 34816 / 16; i += NTHR) ((u32x4*)ST0)[i] = (u32x4){0u, 0u, 0u, 0u};
    f32x4 accS[8];
#pragma unroll
    for (int c = 0; c < 8; ++c) accS[c] = (f32x4){0.f, 0.f, 0.f, 0.f};
    const int ocg8 = (tid & 15) * 8, otok = tid >> 4;
    const float* gdp = a.in[12] + l * 128 + ocg8;
    const unsigned char* rec0 = a.ws + WS_REC + (size_t)(task * 32) * REC_BYTES;
    bf16x8 aw[4], aq[4], aat[2], ak[2]; f32x4 accP[4]; float gl;
#define SCAN_LD_A(rec) do { _Pragma("unroll") for (int ks = 0; ks < 4; ++ks) aw[ks] = *(const bf16x8*)((const bf16_t*)((rec) + REC_W) + (rt * 16 + l15) * 128 + ks * 32 + q * 8); \
        _Pragma("unroll") for (int t = 0; t < 4; ++t) { const u32x2 uw = *(const u32x2*)((const bf16_t*)((rec) + REC_UT) + ((cb + t) * 16 + l15) * 64 + rt * 16 + q * 4); accP[t] = (f32x4){bflo(uw.x), bfhi(uw.x), bflo(uw.y), bfhi(uw.y)}; } } while (0)
#define SCAN_LD_B(rec) do { _Pragma("unroll") for (int ks = 0; ks < 4; ++ks) aq[ks] = *(const bf16x8*)((const bf16_t*)((rec) + REC_QD) + (rt * 16 + l15) * 128 + ks * 32 + q * 8); \
        _Pragma("unroll") for (int ks = 0; ks < 2; ++ks) aat[ks] = *(const bf16x8*)((const bf16_t*)((rec) + REC_ATT) + (rt * 16 + l15) * 64 + ks * 32 + q * 8); } while (0)
#define SCAN_LD_C(rec, ct) do { _Pragma("unroll") for (int ks = 0; ks < 2; ++ks) ak[ks] = *(const bf16x8*)((const bf16_t*)((rec) + REC_KDT) + (wave * 16 + l15) * 64 + ks * 32 + q * 8); gl = GL[ct]; } while (0)
    SCAN_LD_A(rec0); SCAN_LD_B(rec0); SCAN_LD_C(rec0, task * 32);
    __syncthreads();
#pragma unroll 1
    for (int n = 0; n < 32; ++n) {
        const int np = (n + 1 < 32) ? n + 1 : 31; const unsigned char* recn = rec0 + (size_t)np * REC_BYTES;
        const bf16_t* STc = (n & 1) ? ST1 : ST0; bf16_t* STn = (n & 1) ? ST0 : ST1;
        bf16x8 awN[4]; u32x2 utN[4];
#pragma unroll
        for (int ks = 0; ks < 4; ++ks) awN[ks] = *(const bf16x8*)((const bf16_t*)(recn + REC_W) + (rt * 16 + l15) * 128 + ks * 32 + q * 8);
#pragma unroll
        for (int t = 0; t < 4; ++t) utN[t] = *(const u32x2*)((const bf16_t*)(recn + REC_UT) + ((cb + t) * 16 + l15) * 64 + rt * 16 + q * 4);
        u32x4 zbv[2];
        if (n > 0) {
#pragma unroll
            for (int i = 0; i < 2; ++i) zbv[i] = *(const u32x4*)(P + ((size_t)b * SEQ + (n - 1) * 64 + otok + 32 * i) * NPROJ + C_ZB + h * 128 + ocg8);
        }
        {
#pragma unroll
        for (int th = 0; th < 2; ++th) {
        bf16x8 sb[2][4];
#pragma unroll
        for (int t = 0; t < 2; ++t)
#pragma unroll
            for (int ks = 0; ks < 4; ++ks) sb[t][ks] = *(const bf16x8*)(STc + ((cb + th * 2 + t) * 16 + l15) * 136 + ks * 32 + q * 8);
        SCHED_FENCE();
#pragma unroll
        for (int ks = 0; ks < 4; ++ks)
#pragma unroll
            for (int t = 0; t < 2; ++t) accP[th * 2 + t] = __builtin_amdgcn_mfma_f32_16x16x32_bf16(aw[ks], sb[t][ks], accP[th * 2 + t], 0, 0, 0);
        SCHED_FENCE();
        }
        }
#pragma unroll
        for (int t = 0; t < 4; ++t) { u32x2 w; w.x = pk2(accP[t][0], accP[t][1]); w.y = pk2(accP[t][2], accP[t][3]);
            *(u32x2*)(VT + ((cb + t) * 16 + l15) * 72 + rt * 16 + q * 4) = w; }
        LDS_BAR();
        if (n > 0) {
            const bf16_t* OT = ((n - 1) & 1) ? OT1 : OT0; const f32x4 g0 = *(const f32x4*)gdp, g1 = *(const f32x4*)(gdp + 4); const float gd[8] = {g0[0], g0[1], g0[2], g0[3], g1[0], g1[1], g1[2], g1[3]};
#pragma unroll
            for (int i = 0; i < 2; ++i) { const int tok = otok + 32 * i; float o[8], z[8]; unpack8(*(const u32x4*)(OT + tok * 136 + ocg8), o); unpack8(zbv[i], z);
                u32x4 w; w.x = pk2(o[0] * gd[0] * silu(z[0]), o[1] * gd[1] * silu(z[1])); w.y = pk2(o[2] * gd[2] * silu(z[2]), o[3] * gd[3] * silu(z[3]));
                w.z = pk2(o[4] * gd[4] * silu(z[4]), o[5] * gd[5] * silu(z[5])); w.w = pk2(o[6] * gd[6] * silu(z[6]), o[7] * gd[7] * silu(z[7]));
                *(u32x4*)(YB + ((size_t)b * SEQ + (n - 1) * 64 + tok) * D + h * 128 + ocg8) = w; }
        }
        f32x4 accO[4];
#pragma unroll
        for (int t = 0; t < 4; ++t) accO[t] = (f32x4){0.f, 0.f, 0.f, 0.f};
        {
#pragma unroll
            for (int th = 0; th < 2; ++th) {
            bf16x8 sb2[2][4];
#pragma unroll
            for (int t = 0; t < 2; ++t)
#pragma unroll
                for (int ks = 0; ks < 4; ++ks) sb2[t][ks] = *(const bf16x8*)(STc + ((cb + th * 2 + t) * 16 + l15) * 136 + ks * 32 + q * 8);
            SCHED_FENCE();
#pragma unroll
            for (int ks = 0; ks < 4; ++ks)
#pragma unroll
                for (int t = 0; t < 2; ++t) accO[th * 2 + t] = __builtin_amdgcn_mfma_f32_16x16x32_bf16(sb2[t][ks], aq[ks], accO[th * 2 + t], 0, 0, 0);
            SCHED_FENCE();
            }
        }
        {
            bf16x8 vb[4][2];
#pragma unroll
            for (int t = 0; t < 4; ++t)
#pragma unroll
                for (int ks = 0; ks < 2; ++ks) vb[t][ks] = *(const bf16x8*)(VT + ((cb + t) * 16 + l15) * 72 + ks * 32 + q * 8);
            SCHED_FENCE();
#pragma unroll
            for (int ks = 0; ks < 2; ++ks)
#pragma unroll
                for (int t = 0; t < 4; ++t) accO[t] = __builtin_amdgcn_mfma_f32_16x16x32_bf16(vb[t][ks], aat[ks], accO[t], 0, 0, 0);
            SCHED_FENCE();
        }
        SCAN_LD_B(recn);
        {
            float sq = 0.f;
#pragma unroll
            for (int t = 0; t < 4; ++t) sq += (accO[t][0] * accO[t][0] + accO[t][1] * accO[t][1]) + (accO[t][2] * accO[t][2] + accO[t][3] * accO[t][3]);
            sq += __shfl_xor(sq, 16); sq += __shfl_xor(sq, 32);
            if (q == 0) RED[(wave >> 2) * 64 + rt * 16 + l15] = sq;
        }
#pragma unroll
        for (int c = 0; c < 8; ++c) accS[c] = accS[c] * gl;
#pragma unroll
        for (int hf = 0; hf < 2; ++hf) {
            bf16x8 vb[4][2];
#pragma unroll
            for (int t = 0; t < 4; ++t)
#pragma unroll
                for (int ks = 0; ks < 2; ++ks) vb[t][ks] = *(const bf16x8*)(VT + ((hf * 4 + t) * 16 + l15) * 72 + ks * 32 + q * 8);
            SCHED_FENCE();
#pragma unroll
            for (int ks = 0; ks < 2; ++ks)
#pragma unroll
                for (int t = 0; t < 4; ++t) accS[hf * 4 + t] = __builtin_amdgcn_mfma_f32_16x16x32_bf16(ak[ks], vb[t][ks], accS[hf * 4 + t], 0, 0, 0);
            SCHED_FENCE();
        }
#pragma unroll
        for (int c = 0; c < 8; ++c) { u32x2 w; w.x = pk2(accS[c][0], accS[c][1]); w.y = pk2(accS[c][2], accS[c][3]);
            *(u32x2*)(STn + (c * 16 + l15) * 136 + wave * 16 + q * 4) = w; }
        SCAN_LD_C(recn, task * 32 + np);
        LDS_BAR();
        {
            bf16_t* OT = (n & 1) ? OT1 : OT0;
            const float rs = rsqrtf((RED[rt * 16 + l15] + RED[64 + rt * 16 + l15]) * (1.f / 128.f) + EPS);
#pragma unroll
            for (int t = 0; t < 4; ++t) { u32x2 w; w.x = pk2(accO[t][0] * rs, accO[t][1] * rs); w.y = pk2(accO[t][2] * rs, accO[t][3] * rs);
                *(u32x2*)(OT + (rt * 16 + l15) * 136 + (cb + t) * 16 + q * 4) = w; }
        }
#pragma unroll
        for (int ks = 0; ks < 4; ++ks) aw[ks] = awN[ks];
#pragma unroll
        for (int t = 0; t < 4; ++t) accP[t] = (f32x4){bflo(utN[t].x), bfhi(utN[t].x), bflo(utN[t].y), bfhi(utN[t].y)};
    }
    __syncthreads();
    {
        const f32x4 g0 = *(const f32x4*)gdp, g1 = *(const f32x4*)(gdp + 4); const float gd[8] = {g0[0], g0[1], g0[2], g0[3], g1[0], g1[1], g1[2], g1[3]};
#pragma unroll
        for (int i = 0; i < 2; ++i) { const int tok = otok + 32 * i; float o[8], z[8]; unpack8(*(const u32x4*)(OT1 + tok * 136 + ocg8), o);
            unpack8(*(const u32x4*)(P + ((size_t)b * SEQ + 31 * 64 + tok) * NPROJ + C_ZB + h * 128 + ocg8), z);
            u32x4 w; w.x = pk2(o[0] * gd[0] * silu(z[0]), o[1] * gd[1] * silu(z[1])); w.y = pk2(o[2] * gd[2] * silu(z[2]), o[3] * gd[3] * silu(z[3]));
            w.z = pk2(o[4] * gd[4] * silu(z[4]), o[5] * gd[5] * silu(z[5])); w.w = pk2(o[6] * gd[6] * silu(z[6]), o[7] * gd[7] * silu(z[7]));
            *(u32x4*)(YB + ((size_t)b * SEQ + 31 * 64 + tok) * D + h * 128 + ocg8) = w; }
    }
#undef SCAN_LD_A
#undef SCAN_LD_B
#undef SCAN_LD_C
    float* So = a.out + O_GP + (((size_t)l * NB + b) * 8 + h) * 16384;
#pragma unroll
    for (int c = 0; c < 8; ++c)
#pragma unroll
        for (int jj = 0; jj < 4; ++jj) So[(wave * 16 + q * 4 + jj) * 128 + c * 16 + l15] = accS[c][jj];
    __syncthreads();
}
__device__ __forceinline__ void task_conv_state_prompt(const Args& a, int l, int tid) {
    asm volatile("" : "+v"(tid));
    const bf16_t* P = (const bf16_t*)(a.ws + WS_PROJ);
    for (int i = tid; i < NB * 3 * CONVD; i += NTHR) { const int c = i % CONVD, r = (i / CONVD) % 3, b = i / (3 * CONVD);
        a.out[O_CP + (size_t)l * NB * 3 * CONVD + i] = bf1(P[(size_t)(b * SEQ + SEQ - 3 + r) * NPROJ + C_QKV + c]); }
}
template <int NT>
__device__ __forceinline__ void sg_core(const bf16_t* Arow, const bf16_t* Brow, f32x4 (&acc)[NT]) {
    constexpr int KB = (NT == 1) ? 8 : 4;
#pragma unroll 1
    for (int k0 = 0; k0 < 32; k0 += KB) {
        bf16x8 af[KB], bfr[KB][NT];
#pragma unroll
        for (int u = 0; u < KB; ++u) { af[u] = *(const bf16x8*)(Arow + (k0 + u) * 32);
#pragma unroll
            for (int t = 0; t < NT; ++t) bfr[u][t] = *(const bf16x8*)(Brow + (size_t)t * 16 * D + (k0 + u) * 32); }
        SCHED_FENCE();
#pragma unroll
        for (int u = 0; u < KB; ++u)
#pragma unroll
            for (int t = 0; t < NT; ++t) acc[t] = __builtin_amdgcn_mfma_f32_16x16x32_bf16(bfr[u][t], af[u], acc[t], 0, 0, 0);
        SCHED_FENCE();
    }
}
__device__ __forceinline__ void sg_core2(const bf16_t* A0, const bf16_t* B0, const bf16_t* A1, const bf16_t* B1, f32x4& acc0, f32x4& acc1) {
#pragma unroll 1
    for (int k0 = 0; k0 < 32; k0 += 8) {
        bf16x8 a0[8], b0[8], a1[8], b1[8];
#pragma unroll
        for (int u = 0; u < 8; ++u) { a0[u] = *(const bf16x8*)(A0 + (k0 + u) * 32); b0[u] = *(const bf16x8*)(B0 + (k0 + u) * 32); a1[u] = *(const bf16x8*)(A1 + (k0 + u) * 32); b1[u] = *(const bf16x8*)(B1 + (k0 + u) * 32); }
        SCHED_FENCE();
#pragma unroll
        for (int u = 0; u < 8; ++u) { acc0 = __builtin_amdgcn_mfma_f32_16x16x32_bf16(b0[u], a0[u], acc0, 0, 0, 0); acc1 = __builtin_amdgcn_mfma_f32_16x16x32_bf16(b1[u], a1[u], acc1, 0, 0, 0); }
        SCHED_FENCE();
    }
}
__device__ __forceinline__ void small_p1(const Args& a, int l, int it, int tid) {
    asm volatile("" : "+v"(tid));
    const int wave = tid >> 6, lane = tid & 63, l15 = lane & 15, q = lane >> 4;
    const bf16_t* H = (const bf16_t*)(a.ws + WS_H); const bf16_t* W = (const bf16_t*)(a.ws + WS_W1T) + (size_t)l * NW1 * D; bf16_t* P = (bf16_t*)(a.ws + WS_PROJ); float* AB = (float*)(a.ws + WS_AB);
    if (it < 64) {
#pragma unroll 1
        for (int rb2 = 0; rb2 < 2; ++rb2) {
            const int row = it * 256 + rb2 * 128 + wave * 16 + l15; f32x4 acc[1] = {(f32x4){0.f, 0.f, 0.f, 0.f}};
            sg_core<1>(H + (size_t)row * D + q * 8, W + (size_t)(NPROJ + l15) * D + q * 8, acc);
            *(f32x4*)(AB + (size_t)row * 16 + q * 4) = acc[0];
        }
    } else {
        const int ct = it - 64, n0 = ct * 64, row = TP + wave * 16 + l15; f32x4 acc[4];
#pragma unroll
        for (int t = 0; t < 4; ++t) acc[t] = (f32x4){0.f, 0.f, 0.f, 0.f};
        sg_core<4>(H + (size_t)row * D + q * 8, W + (size_t)(n0 + l15) * D + q * 8, acc);
        if (ct < 144) {
#pragma unroll
            for (int t = 0; t < 4; ++t) { u32x2 w; w.x = pk2(acc[t][0], acc[t][1]); w.y = pk2(acc[t][2], acc[t][3]); *(u32x2*)(P + (size_t)row * NPROJ + n0 + t * 16 + q * 4) = w; }
        } else *(f32x4*)(AB + (size_t)row * 16 + q * 4) = acc[0];
    }
}
__device__ __forceinline__ void small_p4(const Args& a, int l, int it, int tid) {
    asm volatile("" : "+v"(tid));
    const int wave = tid >> 6, lane = tid & 63, l15 = lane & 15, q = lane >> 4; const int n0 = it * 16, row = TP + wave * 16 + l15;
    const bf16_t* P = (const bf16_t*)(a.ws + WS_PROJ);
    f32x4 accA[1] = {(f32x4){0.f, 0.f, 0.f, 0.f}}, accB[1] = {(f32x4){0.f, 0.f, 0.f, 0.f}};
    sg_core2((const bf16_t*)(a.ws + WS_YA) + (size_t)row * D + q * 8, (const bf16_t*)(a.ws + WS_WPA) + (size_t)l * D * D + (size_t)(n0 + l15) * D + q * 8,
             (const bf16_t*)(a.ws + WS_YB) + (size_t)row * D + q * 8, (const bf16_t*)(a.ws + WS_WPB) + (size_t)l * D * D + (size_t)(n0 + l15) * D + q * 8, accA[0], accB[0]);
    const u32x2 ga = *(const u32x2*)(P + (size_t)row * NPROJ + C_GA + n0 + q * 4), gb = *(const u32x2*)(P + (size_t)row * NPROJ + C_GB + n0 + q * 4);
    const float m0 = sigm(bflo(ga.x)) * accA[0][0] + sigm(bflo(gb.x)) * accB[0][0], m1 = sigm(bfhi(ga.x)) * accA[0][1] + sigm(bfhi(gb.x)) * accB[0][1];
    const float m2 = sigm(bflo(ga.y)) * accA[0][2] + sigm(bflo(gb.y)) * accB[0][2], m3 = sigm(bfhi(ga.y)) * accA[0][3] + sigm(bfhi(gb.y)) * accB[0][3];
    u32x2 w; w.x = pk2(m0, m1); w.y = pk2(m2, m3);
    *(u32x2*)((bf16_t*)(a.ws + WS_MERGED) + (size_t)row * D + n0 + q * 4) = w;
}
__device__ __forceinline__ void small_p5(const Args& a, int l, int it, int tid) {
    asm volatile("" : "+v"(tid));
    const int wave = tid >> 6, lane = tid & 63, l15 = lane & 15, q = lane >> 4; const int n0 = it * 16, row = TP + wave * 16 + l15;
    f32x4 acc[1] = {(f32x4){0.f, 0.f, 0.f, 0.f}};
    sg_core<1>((const bf16_t*)(a.ws + WS_MERGED) + (size_t)row * D + q * 8, (const bf16_t*)(a.ws + WS_WOUT) + (size_t)l * D * D + (size_t)(n0 + l15) * D + q * 8, acc);
    { u32x2 w; w.x = pk2(acc[0][0], acc[0][1]); w.y = pk2(acc[0][2], acc[0][3]); *(u32x2*)((bf16_t*)(a.ws + WS_TMP) + (size_t)row * D + n0 + q * 4) = w; }
}
#define XB_TMO      128
#define XB_XCNT(j)  (256  + 64 * (j))
#define XB_XSUB(j)  (1280 + 64 * (j))
#define XB_XGEN(j)  (2304 + 64 * (j))
#define XB_TOP      3328
#define XB_TOPGEN   3392
#define XCD_BAR_WORDS 3456
#define XB_SPIN_CAP (1u << 18)

__device__ __forceinline__ unsigned xb_ld(unsigned* p)              { return __hip_atomic_load(p, __ATOMIC_RELAXED, __HIP_MEMORY_SCOPE_AGENT); }
__device__ __forceinline__ unsigned xb_add(unsigned* p, unsigned v) { return __hip_atomic_fetch_add(p, v, __ATOMIC_RELAXED, __HIP_MEMORY_SCOPE_AGENT); }
__device__ __forceinline__ unsigned xb_xcc_id() { return (unsigned)__builtin_amdgcn_s_getreg((3 << 11) | 20) & 0xFu; }
#define XB_SPIN(cond, bar) do { unsigned _sp = 0; while (cond) { __builtin_amdgcn_s_sleep(1); \
    if ((++_sp & 255u) == 0u) { if (xb_ld(&(bar)[XB_TMO])) break; if (_sp > XB_SPIN_CAP) { atomicAdd(&(bar)[XB_TMO], 1u); break; } } } } while (0)

struct XcdBarrier {
    unsigned* bar; unsigned x;
    volatile LAS unsigned* st;
};

__device__ __forceinline__ XcdBarrier xcd_barrier_post(unsigned* bar, volatile LAS unsigned* st) {
    XcdBarrier b; b.bar = bar; b.x = xb_xcc_id(); b.st = st;
    if (threadIdx.x == 0) (void)xb_add(&bar[XB_XCNT(b.x)], 1u);
    return b;
}
__device__ __forceinline__ void xcd_barrier_complete(unsigned* bar, unsigned x, unsigned& nloc, unsigned& nx) {
    const unsigned G = gridDim.x * gridDim.y * gridDim.z;
    unsigned sum, cnt, mine, sp = 0u;
    for (;;) {
        sum = 0u; cnt = 0u; mine = 0u;
#pragma unroll
        for (unsigned j = 0; j < 16; ++j) { const unsigned c = xb_ld(&bar[XB_XCNT(j)]); sum += c; cnt += (c > 0u) ? 1u : 0u; mine = (j == x) ? c : mine; }
        if (sum == G) break;
        __builtin_amdgcn_s_sleep(1);
        if ((++sp & 255u) == 0u) { if (xb_ld(&bar[XB_TMO])) break; if (sp > XB_SPIN_CAP) { atomicAdd(&bar[XB_TMO], 1u); break; } }
    }
    nloc = mine > 0u ? mine : 1u; nx = cnt > 0u ? cnt : 1u;
}

__device__ __forceinline__ void xcd_barrier(const XcdBarrier& b) {
    asm volatile("s_waitcnt vmcnt(0)" ::: "memory");
    __syncthreads();
    if (threadIdx.x == 0) {
        unsigned* bar = b.bar;
        __builtin_amdgcn_s_waitcnt(0);
        unsigned nloc = b.st[0], nx = b.st[1];
        if (nloc == 0u) { xcd_barrier_complete(bar, b.x, nloc, nx); b.st[0] = nloc; b.st[1] = nx; }
        const unsigned old = xb_add(&bar[XB_XSUB(b.x)], 1u);
        const unsigned gen = old / nloc;
        if (old + 1u == (gen + 1u) * nloc) {
            __builtin_amdgcn_fence(__ATOMIC_RELEASE, "agent");
            asm volatile("s_waitcnt vmcnt(0)" ::: "memory");
            const unsigned og = xb_add(&bar[XB_TOP], 1u);
            const unsigned tg = og / nx;
            if (og + 1u == (tg + 1u) * nx) xb_add(&bar[XB_TOPGEN], 1u);
            else XB_SPIN(xb_ld(&bar[XB_TOPGEN]) == tg, bar);
            __builtin_amdgcn_fence(__ATOMIC_ACQUIRE, "agent");
            xb_add(&bar[XB_XGEN(b.x)], 1u);
            asm volatile("s_waitcnt vmcnt(0)" ::: "memory");
        } else {
            XB_SPIN(xb_ld(&bar[XB_XGEN(b.x)]) == gen, bar);
            __builtin_amdgcn_fence(__ATOMIC_ACQUIRE, "agent");
            asm volatile("s_waitcnt vmcnt(0)" ::: "memory");
        }
    }
    __syncthreads();
}
__global__ void __launch_bounds__(NTHR) mega_fwd(Args a) {
    extern __shared__ __attribute__((aligned(16))) unsigned char lds[];
    cg::grid_group grid = cg::this_grid();
    const int tid = threadIdx.x, wg = blockIdx.x, G = gridDim.x;
    bf16_t* H = (bf16_t*)(a.ws + WS_H); bf16_t* PROJ = (bf16_t*)(a.ws + WS_PROJ); float* AB = (float*)(a.ws + WS_AB);
    bf16_t* YA = (bf16_t*)(a.ws + WS_YA); bf16_t* YB = (bf16_t*)(a.ws + WS_YB); float* TMP = (float*)(a.ws + WS_TMP); bf16_t* MG = (bf16_t*)(a.ws + WS_MERGED);
    #ifndef NO_P0
    volatile LAS unsigned* bst = (volatile LAS unsigned*)((LAS unsigned char*)lds + LDS_BYTES - 16);
    if (tid < 4) bst[tid] = 0u;
    __syncthreads();
    if (wg == 0) { for (int i = tid; i < XCD_BAR_WORDS; i += NTHR) ((unsigned*)a.ws)[i] = 0u; }
    phase_prologue(a, lds, wg, G, tid);
#endif
    grid.sync();
    const XcdBarrier bar = xcd_barrier_post((unsigned*)a.ws, bst);
#pragma unroll 1
    for (int l = 0; l < DEPTH; ++l) {
#ifndef NO_P1
        {
            pg8::Gemm g{H, (const bf16_t*)(a.ws + WS_W1T) + (size_t)l * NW1 * D, TP, NPROJ, D}; pg8::StaticOrder S; S.init(TP, NPROJ, G, wg);
            Epi1 E{PROJ, AB}; pg8::gemm_phase<Epi1, pg8::StaticOrder>((LAS unsigned char*)lds, g, S, E, nullptr);
            for (int it = wg; it < 64 + 145; it += G) small_p1(a, l, it, tid);
        }
#endif
        xcd_barrier(bar);
#ifndef NO_P2
        phase_vrstd(a, wg, G, tid);
        for (int t = wg; t < NB * 8 * 16; t += G) task_prep2(a, l, lds, NB * 8 * 16 - 1 - t, tid);
#endif
        xcd_barrier(bar);
        {
#ifndef NO_SCAN
            for (int t = wg; t < 64; t += G) task_scan(a, l, lds, t, tid);
#endif
            const int o = (G > 64) ? wg - 64 : wg, stride = (G > 64) ? G - 64 : G;
#ifndef NO_P3O
            if (o >= 0) {
                constexpr int N_DS = DB * 8, N_GP = 1024, N_GS = DB / 8, N_ALL = N_DS + N_GP + N_GS + 1;
                for (int it = o; it < N_ALL; it += stride) {
                    if (it < N_DS) task_delta_sample(a, l, lds, it, tid);
                    else if (it < N_DS + N_GP) task_gmlp_prompt(a, l, lds, N_GP - 1 - (it - N_DS), tid);
                    else if (it < N_DS + N_GP + N_GS) task_gmlp_sample(a, l, it - N_DS - N_GP, tid);
                    else task_conv_state_prompt(a, l, tid);
                }
                if (l + 1 < DEPTH) { __syncthreads(); phase_weights(a, lds, l + 1, o, stride, tid); }
            }
#endif
        }
        xcd_barrier(bar);
#ifndef NO_P4
        {
            PairOrder S; S.init(TP, D, G, wg);
            { pg8::Gemm g{YA, (const bf16_t*)(a.ws + WS_WPA) + (size_t)l * D * D, TP, D, D}; Epi2ab E{PROJ, MG}; pg8::gemm_phase<Epi2ab, PairOrder>((LAS unsigned char*)lds, g, S, E, nullptr); }
            for (int it = wg; it < 64; it += G) small_p4(a, l, it, tid);
        }
#endif
        xcd_barrier(bar);
#ifndef NO_P5
        {
            pg8::StaticOrder S; S.init(TP, D, G, wg);
            pg8::Gemm g{MG, (const bf16_t*)(a.ws + WS_WOUT) + (size_t)l * D * D, TP, D, D}; Epi3 E{(bf16_t*)(a.ws + WS_TMP)}; pg8::gemm_phase<Epi3, pg8::StaticOrder>((LAS unsigned char*)lds, g, S, E, nullptr);
            for (int it = wg; it < 64; it += G) small_p5(a, l, it, tid);
        }
#endif
        xcd_barrier(bar);
#ifndef NO_P6
        phase_residual(a, l, wg, G, tid);
#endif
        xcd_barrier(bar);
    }
}
extern "C" void kernel_launch(void* const* d_in, const int* in_sizes, int n_in, void* d_out, int out_size, void* d_ws, size_t ws_size, hipStream_t stream) {
    static int grid = 0;
    if (grid == 0) {
        int dev = 0, cus = 0, per_cu = 0;
        hipGetDevice(&dev); hipDeviceGetAttribute(&cus, hipDeviceAttributeMultiprocessorCount, dev);
        if (hipFuncSetAttribute((const void*)mega_fwd, hipFuncAttributeMaxDynamicSharedMemorySize, LDS_BYTES) != hipSuccess) fprintf(stderr, "hipFuncSetAttribute failed\n");
        if (hipOccupancyMaxActiveBlocksPerMultiprocessor(&per_cu, (const void*)mega_fwd, NTHR, LDS_BYTES) != hipSuccess || per_cu < 1) { fprintf(stderr, "occupancy query: %d\n", per_cu); per_cu = 1; }
        (void)hipGetLastError();
        grid = cus;
        if (ws_size < WS_END) { fprintf(stderr, "workspace too small: %zu < %zu\n", ws_size, (size_t)WS_END); grid = -1; }
    }
    if (grid < 0) return;
    Args a{};
    for (int i = 0; i < 17; ++i) a.in[i] = (const float*)d_in[i];
    a.out = (float*)d_out; a.ws = (unsigned char*)d_ws;
    void* args[] = {&a};
    hipError_t e = hipLaunchCooperativeKernel((const void*)mega_fwd, dim3(grid), dim3(NTHR), args, LDS_BYTES, stream);
    if (e != hipSuccess) fprintf(stderr, "cooperative launch failed: %s (grid %d)\n", hipGetErrorString(e), grid);
}
```
